# Optimizing an MI355X kernel written in HIP

```python
import jax, jax.numpy as jnp
from jax import lax
import numpy as np

D_MODEL = 1024
BATCH = 8
SEQ = 2048
DEPTH = 2

GRID_W = 64
CTX_LEN = 256
D_MIX = D_MODEL
A_HEADS = 4
A_DH = 64
A_DV = 2 * A_DH
A_WIDTH = A_HEADS * A_DV
M_HEADS = 4
M_WIDTH = D_MIX - A_WIDTH
M_DH = M_WIDTH // M_HEADS
CONV_K = 5
CHUNK = 64
Q_BLOCK = 128
ROPE_BASE = 10000.0
ROPE_PAIRS_PER_AXIS = A_DH // 4
D_FF = 256 * ((8 * D_MODEL // 3 + 255) // 256)
N_EXPERTS = 8
TOP_K = 2
D_FF_EXPERT = 7 * D_MODEL // 2
N_DENSE = (DEPTH + 1) // 2
N_MOE = DEPTH // 2
EPS = 1e-6
N_GATES = 4 * M_HEADS
IN_COLS = 3 * A_WIDTH + 4 * M_WIDTH + N_GATES
SPLITS = (A_WIDTH, 2 * A_WIDTH, 3 * A_WIDTH, 3 * A_WIDTH + M_WIDTH, 3 * A_WIDTH + 2 * M_WIDTH,
          3 * A_WIDTH + 3 * M_WIDTH, 3 * A_WIDTH + 4 * M_WIDTH)

kernel_name = "hybrid_diffattn_mlstm_moe_dit"


def rms_norm(x, g):
    xf = x.astype(jnp.float32)
    y = xf * lax.rsqrt(jnp.mean(xf * xf, axis=-1, keepdims=True) + EPS)
    return (y * g.astype(jnp.float32)).astype(x.dtype)


def adaln(cvec, w, b):
    m = jax.nn.silu(cvec) @ w + b
    return jnp.split(m[..., None, :], 6, axis=-1)


def modulate(x, g, shift, scale):
    return rms_norm(x, g) * (1.0 + scale) + shift


def axial_rope_tables(n_tokens):
    rows = n_tokens // GRID_W
    row = jnp.repeat(jnp.arange(rows, dtype=jnp.float32), GRID_W)
    col = jnp.tile(jnp.arange(GRID_W, dtype=jnp.float32), rows)
    inv = ROPE_BASE ** (-jnp.arange(ROPE_PAIRS_PER_AXIS, dtype=jnp.float32) / ROPE_PAIRS_PER_AXIS)
    ang = jnp.concatenate([row[:, None] * inv, col[:, None] * inv], axis=-1)
    return jnp.cos(ang), jnp.sin(ang)


def apply_rope(x, cos, sin):
    c = cos[None, :, None, None, :].astype(x.dtype)
    s = sin[None, :, None, None, :].astype(x.dtype)
    x1, x2 = x[..., :A_DH // 2], x[..., A_DH // 2:]
    return jnp.concatenate([x1 * c - x2 * s, x1 * s + x2 * c], axis=-1)


def diff_heads(aq, ak, av, q_g, k_g):
    B, T, _ = aq.shape
    q = rms_norm(aq.reshape(B, T, A_HEADS, 2, A_DH), q_g)
    k = rms_norm(ak.reshape(B, T, A_HEADS, 2, A_DH), k_g)
    v = av.reshape(B, T, A_HEADS, A_DV)
    return q, k, v


def diff_attention(q, k, v, lam):
    s = jnp.einsum('bqhcd,bkhcd->bhcqk', q, k).astype(jnp.float32) * (A_DH ** -0.5)
    p = jax.nn.softmax(s, axis=-1)
    a = p[:, :, 0] - lam * p[:, :, 1]
    return jnp.einsum('bhqk,bkhv->bqhv', a.astype(v.dtype), v)


def blocked_latent_attention(q, k_all, v_all, lam):
    B, T = q.shape[:2]
    nb = T // Q_BLOCK
    qb = jnp.moveaxis(q.reshape(B, nb, Q_BLOCK, A_HEADS, 2, A_DH), 1, 0)

    def one_block(blk):
        return diff_attention(blk, k_all, v_all, lam)

    out = lax.map(one_block, qb)
    return jnp.moveaxis(out, 0, 1).reshape(B, T, A_HEADS, A_DV)


def diff_post(o, g, lam_init):
    B, T = o.shape[:2]
    return (rms_norm(o, g) * (1.0 - lam_init).astype(o.dtype)).reshape(B, T, A_WIDTH)


def centred_dwconv(x, w, b):
    pad = CONV_K // 2
    y = lax.conv_general_dilated(x, w[:, None, :].astype(x.dtype), window_strides=(1,),
                                 padding=[(pad, pad)], dimension_numbers=('NWC', 'WIO', 'NWC'),
                                 feature_group_count=x.shape[-1])
    return y + b


def to_heads(a):
    B, T, _ = a.shape
    return a.reshape(B, T, M_HEADS, M_DH).transpose(0, 2, 1, 3).astype(jnp.float32)


def mlstm_inputs(mq, mk, mv, gates, conv_w, conv_b, gate_b):
    B, T, _ = mq.shape
    qk = jax.nn.silu(centred_dwconv(jnp.concatenate([mq, mk], axis=-1), conv_w, conv_b))
    q, k = jnp.split(qk, 2, axis=-1)
    g = (gates.reshape(B, T, 2, 2, M_HEADS) + gate_b).astype(jnp.float32).transpose(2, 3, 0, 4, 1)
    log_i = g[:, 0]
    log_f = jax.nn.log_sigmoid(g[:, 1])
    return to_heads(q), to_heads(k) * (M_DH ** -0.5), to_heads(mv), log_i, log_f


def zero_state(B):
    return (jnp.zeros((B, M_HEADS, M_DH, M_DH), jnp.float32),
            jnp.zeros((B, M_HEADS, M_DH), jnp.float32),
            jnp.zeros((B, M_HEADS), jnp.float32))


def mlstm_chunkwise(q, k, v, log_i, log_f, state):
    B, H, T, dk = q.shape
    dv = v.shape[-1]
    nc = T // CHUNK

    def to_chunks(a):
        return jnp.moveaxis(a.reshape(B, H, nc, CHUNK, *a.shape[3:]), 2, 0)

    causal = jnp.tril(jnp.ones((CHUNK, CHUNK), dtype=bool))

    def step(carry, inp):
        C, n, m = carry
        qb, kb, vb, li, lf = inp
        b = jnp.cumsum(lf, axis=-1)
        dmat = jnp.where(causal, b[..., :, None] - b[..., None, :] + li[..., None, :], -jnp.inf)
        inter = b + m[..., None]
        m_t = jnp.maximum(inter, jnp.max(dmat, axis=-1))
        w_intra = jnp.exp(dmat - m_t[..., None])
        w_inter = jnp.exp(inter - m_t)
        s = jnp.einsum('bhld,bhsd->bhls', qb, kb) * w_intra
        num = jnp.einsum('bhls,bhsv->bhlv', s, vb) + w_inter[..., None] * jnp.einsum('bhld,bhdv->bhlv', qb, C)
        den = jnp.sum(s, axis=-1) + w_inter * jnp.einsum('bhld,bhd->bhl', qb, n)
        h = num / jnp.maximum(jnp.abs(den), jnp.exp(-m_t))[..., None]
        b_last = b[..., -1]
        w_log = b_last[..., None] - b + li
        m_new = jnp.maximum(b_last + m, jnp.max(w_log, axis=-1))
        w = jnp.exp(w_log - m_new[..., None])
        decay = jnp.exp(b_last + m - m_new)
        C_new = decay[..., None, None] * C + jnp.einsum('bhsd,bhsv->bhdv', kb * w[..., None], vb)
        n_new = decay[..., None] * n + jnp.einsum('bhs,bhsd->bhd', w, kb)
        return (C_new, n_new, m_new), h

    state, hs = lax.scan(step, state, (to_chunks(q), to_chunks(k), to_chunks(v), to_chunks(log_i), to_chunks(log_f)))
    return jnp.moveaxis(hs, 0, 2).reshape(B, H, T, dv), state


def flip_t(a):
    return jnp.flip(a, axis=2)


def bidir_mlstm(q, k, v, log_i, log_f, init_f, init_b):
    h_f, st_f = mlstm_chunkwise(q, k, v, log_i[0], log_f[0], init_f)
    h_b, st_b = mlstm_chunkwise(flip_t(q), flip_t(k), flip_t(v), flip_t(log_i[1]), flip_t(log_f[1]), init_b)
    return h_f + flip_t(h_b), st_f, st_b


def mlstm_post(h, o, g):
    B, T, _ = o.shape
    hn = rms_norm(jnp.transpose(h, (0, 2, 1, 3)), g.reshape(M_HEADS, M_DH)).astype(o.dtype)
    return jax.nn.sigmoid(o) * hn.reshape(B, T, M_WIDTH)


def hybrid_mixer(h_lat, h_ctx, cos, sin, w_in_l, w_out_l, q_g, k_g, lam, lam_init, subln_g_l,
                 conv_w_l, conv_b_l, gate_b_l, mnorm_g_l, need_ctx):
    pl = jnp.split(h_lat @ w_in_l, SPLITS, axis=-1)
    pc = jnp.split(h_ctx @ w_in_l, SPLITS, axis=-1)
    ql, kl, vl = diff_heads(pl[0], pl[1], pl[2], q_g, k_g)
    ql, kl = apply_rope(ql, cos, sin), apply_rope(kl, cos, sin)
    qc, kc, vc = diff_heads(pc[0], pc[1], pc[2], q_g, k_g)
    k_all = jnp.concatenate([kl, kc], axis=1)
    v_all = jnp.concatenate([vl, vc], axis=1)
    a_lat = diff_post(blocked_latent_attention(ql, k_all, v_all, lam), subln_g_l, lam_init)
    mc = mlstm_inputs(pc[3], pc[4], pc[5], pc[7], conv_w_l, conv_b_l, gate_b_l)
    ml = mlstm_inputs(pl[3], pl[4], pl[5], pl[7], conv_w_l, conv_b_l, gate_b_l)
    z = zero_state(h_lat.shape[0])
    hc_sum, st_f, st_b = bidir_mlstm(mc[0], mc[1], mc[2], mc[3], mc[4], z, z)
    hl_sum, _, _ = bidir_mlstm(ml[0], ml[1], ml[2], ml[3], ml[4], st_f, st_b)
    m_lat = mlstm_post(hl_sum, pl[6], mnorm_g_l)
    out_lat = jnp.concatenate([a_lat, m_lat], axis=-1) @ w_out_l
    out_ctx = None
    if need_ctx:
        a_ctx = diff_post(diff_attention(qc, kc, vc, lam), subln_g_l, lam_init)
        m_ctx = mlstm_post(hc_sum, pc[6], mnorm_g_l)
        out_ctx = jnp.concatenate([a_ctx, m_ctx], axis=-1) @ w_out_l
    return out_lat, out_ctx


def swiglu(h, w1, w3, w2):
    return (jax.nn.silu(h @ w1) * (h @ w3)) @ w2


def moe_swiglu(h, w_r, w1, w3, w2):
    B, T, D = h.shape
    t = h.reshape(B * T, D)
    logits = (t @ w_r).astype(jnp.float32)
    top_val, top_idx = lax.top_k(logits, TOP_K)
    top_w = jax.nn.softmax(top_val, axis=-1)
    comb = jnp.sum(jax.nn.one_hot(top_idx, N_EXPERTS, dtype=jnp.float32) * top_w[..., None], axis=1).astype(h.dtype)
    out = jnp.zeros_like(t)
    for e in range(N_EXPERTS):
        out = out + comb[:, e:e + 1] * swiglu(t, w1[e], w3[e], w2[e])
    return out.reshape(B, T, D)


def channel_mixer(h, l, ffn_w1, ffn_w3, ffn_w2, router_w, moe_w1, moe_w3, moe_w2):
    j = l // 2
    if l % 2 == 0:
        return swiglu(h, ffn_w1[j], ffn_w3[j], ffn_w2[j])
    return moe_swiglu(h, router_w[j], moe_w1[j], moe_w3[j], moe_w2[j])


def setup_inputs(seed: int = 0) -> dict:
    key = jax.random.key(seed)
    ks = jax.random.split(key, 32)
    f32 = jnp.float32

    def nrm(k, shape, scale):
        return jax.random.normal(k, shape, f32) * scale

    D = D_MODEL
    i_b = nrm(ks[19], (DEPTH, 2, M_HEADS), 0.1)
    f_b = jnp.linspace(3.0, 6.0, M_HEADS, dtype=f32)[None, None, :] + nrm(ks[20], (DEPTH, 2, M_HEADS), 0.1)
    return {
        'x': nrm(ks[0], (BATCH, SEQ, D), 1.0),
        'c': nrm(ks[1], (BATCH, D), 1.0),
        'ctx': nrm(ks[2], (BATCH, CTX_LEN, D), 1.0),
        'c_ctx': nrm(ks[3], (D,), 1.0),
        'ada_w': nrm(ks[4], (DEPTH, D, 6 * D), 0.5 * D ** -0.5),
        'ada_b': nrm(ks[5], (DEPTH, 6 * D), 0.02),
        'norm1_g': 1.0 + nrm(ks[6], (DEPTH, D), 0.05),
        'norm2_g': 1.0 + nrm(ks[7], (DEPTH, D), 0.05),
        'w_in': nrm(ks[8], (DEPTH, D, IN_COLS), D ** -0.5),
        'w_out': nrm(ks[9], (DEPTH, D_MIX, D), D_MIX ** -0.5),
        'q_norm_g': 1.0 + nrm(ks[10], (DEPTH, A_DH), 0.05),
        'k_norm_g': 1.0 + nrm(ks[11], (DEPTH, A_DH), 0.05),
        'lambda_q1': nrm(ks[12], (DEPTH, A_DH), 0.1),
        'lambda_k1': nrm(ks[13], (DEPTH, A_DH), 0.1),
        'lambda_q2': nrm(ks[14], (DEPTH, A_DH), 0.1),
        'lambda_k2': nrm(ks[15], (DEPTH, A_DH), 0.1),
        'subln_g': 1.0 + nrm(ks[16], (DEPTH, A_DV), 0.05),
        'conv_w': nrm(ks[17], (DEPTH, CONV_K, 2 * M_WIDTH), CONV_K ** -0.5),
        'conv_b': nrm(ks[18], (DEPTH, 2 * M_WIDTH), 0.02),
        'gate_b': jnp.stack([i_b, f_b], axis=2),
        'mnorm_g': 1.0 + nrm(ks[21], (DEPTH, M_WIDTH), 0.05),
        'ffn_w1': nrm(ks[22], (N_DENSE, D, D_FF), D ** -0.5),
        'ffn_w3': nrm(ks[23], (N_DENSE, D, D_FF), D ** -0.5),
        'ffn_w2': nrm(ks[24], (N_DENSE, D_FF, D), D_FF ** -0.5),
        'router_w': nrm(ks[25], (N_MOE, D, N_EXPERTS), D ** -0.5),
        'moe_w1': nrm(ks[26], (N_MOE, N_EXPERTS, D, D_FF_EXPERT), D ** -0.5),
        'moe_w3': nrm(ks[27], (N_MOE, N_EXPERTS, D, D_FF_EXPERT), D ** -0.5),
        'moe_w2': nrm(ks[28], (N_MOE, N_EXPERTS, D_FF_EXPERT, D), D_FF_EXPERT ** -0.5),
    }


def reference(x, c, ctx, c_ctx, ada_w, ada_b, norm1_g, norm2_g, w_in, w_out, q_norm_g, k_norm_g,
              lambda_q1, lambda_k1, lambda_q2, lambda_k2, subln_g, conv_w, conv_b, gate_b, mnorm_g,
              ffn_w1, ffn_w3, ffn_w2, router_w, moe_w1, moe_w3, moe_w2):
    cos, sin = axial_rope_tables(x.shape[1])
    for l in range(DEPTH):
        last = l == DEPTH - 1
        lam_init = 0.8 - 0.6 * jnp.exp(jnp.float32(-0.3 * l))
        lam = (jnp.exp(jnp.sum(lambda_q1[l] * lambda_k1[l]).astype(jnp.float32))
               - jnp.exp(jnp.sum(lambda_q2[l] * lambda_k2[l]).astype(jnp.float32)) + lam_init)
        sh1, sc1, g1, sh2, sc2, g2 = adaln(c, ada_w[l], ada_b[l])
        csh1, csc1, cg1, csh2, csc2, cg2 = adaln(c_ctx, ada_w[l], ada_b[l])
        mix_lat, mix_ctx = hybrid_mixer(
            modulate(x, norm1_g[l], sh1, sc1), modulate(ctx, norm1_g[l], csh1, csc1), cos, sin,
            w_in[l], w_out[l], q_norm_g[l], k_norm_g[l], lam, lam_init, subln_g[l],
            conv_w[l], conv_b[l], gate_b[l], mnorm_g[l], not last)
        x = x + g1 * mix_lat
        x = x + g2 * channel_mixer(modulate(x, norm2_g[l], sh2, sc2), l,
                                   ffn_w1, ffn_w3, ffn_w2, router_w, moe_w1, moe_w3, moe_w2)
        if not last:
            ctx = ctx + cg1 * mix_ctx
            ctx = ctx + cg2 * channel_mixer(modulate(ctx, norm2_g[l], csh2, csc2), l,
                                            ffn_w1, ffn_w3, ffn_w2, router_w, moe_w1, moe_w3, moe_w2)
    return x
```

```cpp
#include <hip/hip_runtime.h>
#include <cstdio>
#include <cstdint>
#include <cmath>
constexpr int NB = 8, T = 2048, D = 1024, CT = 256, ML = NB * T, MC = NB * CT, MR = ML + MC, TT = T + CT;
constexpr int INC = 3600, NQ = 3584;
constexpr int FF = 2816, FFE = 3584, NE = 8;
constexpr int ADA_LD = 6144, ADA_L = 9 * ADA_LD;
constexpr float EPS = 1e-6f, LOG2E = 1.4426950408889634f;
constexpr float QSCALE = 0.125f * LOG2E;
namespace pg8 {
#define PG8_LAS __attribute__((address_space(3)))
typedef unsigned short bf16_t;
typedef short bf16x8 __attribute__((ext_vector_type(8)));
typedef float f32x4 __attribute__((ext_vector_type(4)));
typedef unsigned u32x4 __attribute__((ext_vector_type(4)));
constexpr int BM = 256, BK = 64, HALF = 128, HTB = HALF * BK * 2  , STAGE_BYTES = 8 * HTB, NXCD = 8, WGM = 8;

__host__ __device__ __forceinline__ int lds_byte(int r, int c) { const int st = (r >> 4) * 2 + (c >> 5), rr = r & 15, cc = c & 31, ob = rr * 64 + cc * 2; return st * 1024 + (ob ^ (((ob >> 9) & 1) << 5)); }
__host__ __device__ __forceinline__ void stage_rc(int b, int& R, int& C) { const int st = b / 1024, sb = b % 1024, swz = sb ^ (((sb >> 9) & 1) << 5); R = (st >> 1) * 16 + swz / 64; C = (st & 1) * 32 + (swz % 64) / 2; }
__host__ __device__ __forceinline__ int perm32(int rho) { const int n = rho >> 4, i = rho & 15; return 8 * (i >> 2) + 4 * n + (i & 3); }

struct Unit { int pm, pn, ko; };
struct Gemm { const bf16_t* A; const bf16_t* Bt; int M, N, K, ld; };

struct StaticOrder {
    int nM, nN, nwg, G, c;
    __host__ __device__ void init(int M, int N, int G_, int c_) { nM = M / BM; nN = N / BM; nwg = nM * nN; G = G_; c = c_; }
    __host__ __device__ bool next(int i, Unit& u) const {
        const long L = (long)i * G + c; if (L >= nwg) return false;
        int wgid = (int)L; { const int q = nwg / NXCD, r = nwg % NXCD, xcd = wgid % NXCD, off = wgid / NXCD; wgid = (xcd < r ? xcd * (q + 1) : r * (q + 1) + (xcd - r) * q) + off; }
        const int nig = WGM * nN, gid = wgid / nig, fm = gid * WGM, gsz = (nM - fm) < WGM ? (nM - fm) : WGM;
        u.pm = fm + ((wgid % nig) % gsz); u.pn = (wgid % nig) / gsz; u.ko = 0; return true;
    }
    __device__ __forceinline__ void a_ready(const Unit&) const {}
    __device__ __forceinline__ void done(const Unit&) const {}
};

__device__ __forceinline__ unsigned cvt_pk_bf16(float lo, float hi) { unsigned r; asm volatile("v_cvt_pk_bf16_f32 %0, %1, %2" : "=v"(r) : "v"(lo), "v"(hi)); return r; }
typedef float f32x2 __attribute__((ext_vector_type(2)));
typedef float f32x2_t __attribute__((ext_vector_type(2))); typedef __bf16 bf16x2_t __attribute__((ext_vector_type(2)));
__device__ __forceinline__ unsigned pk2(float lo, float hi) { f32x2_t v = {lo, hi}; bf16x2_t b = __builtin_convertvector(v, bf16x2_t); return __builtin_bit_cast(unsigned, b); }
__device__ __forceinline__ u32x4 pk8(const f32x4 a, const f32x4 b) { u32x4 w; w.x = pk2(a[0], a[1]); w.y = pk2(a[2], a[3]); w.z = pk2(b[0], b[1]); w.w = pk2(b[2], b[3]); return w; }

struct EpiQKV {
    static constexpr bool PERM = true, AFTER_DRAIN = false;
    bf16_t* O; const float* qg; const float* kg; const float* ropeR; const float* ropeC;
    __device__ __forceinline__ void operator()(const f32x4 (&acc)[2][2][4][2], const Unit& u, int wr, int wc, int fr, int fq) const {
        const int row0 = u.pm * BM + wr * 64 + fr;
        if (u.pn >= 4) {
            const int col0 = u.pn * BM + wc * 32 + 8 * fq;
#pragma unroll
            for (int ai = 0; ai < 2; ++ai)
#pragma unroll
                for (int m = 0; m < 4; ++m) { bf16_t* rowp = O + (size_t)(row0 + ai * HALF + m * 16) * NQ + col0;
#pragma unroll
                    for (int bj = 0; bj < 2; ++bj) *(u32x4*)(rowp + bj * HALF) = pk8(acc[ai][bj][m][0], acc[ai][bj][m][1]); }
            return;
        }
        const bool isq = u.pn < 2; const float* gp = (isq ? qg : kg) + 8 * fq; const float qs = isq ? QSCALE : 1.0f;
        const int col0 = u.pn * BM + 64 * wc + 8 * fq;
#pragma unroll
        for (int ai = 0; ai < 2; ++ai)
#pragma unroll
            for (int m = 0; m < 4; ++m) {
                const int row = row0 + ai * HALF + m * 16;
                float ss = 0.f;
#pragma unroll
                for (int bj = 0; bj < 2; ++bj)
#pragma unroll
                    for (int n = 0; n < 2; ++n) { const f32x4 x = acc[ai][bj][m][n]; ss += (x[0] * x[0] + x[1] * x[1]) + (x[2] * x[2] + x[3] * x[3]); }
                ss += __shfl_xor(ss, 16); ss += __shfl_xor(ss, 32);
                const float rstd = 1.0f / sqrtf(ss * (1.0f / 64.0f) + EPS);
                f32x4 y[2][2];
#pragma unroll
                for (int bj = 0; bj < 2; ++bj)
#pragma unroll
                    for (int n = 0; n < 2; ++n) y[bj][n] = acc[ai][bj][m][n] * (rstd * qs) * *(const f32x4*)(gp + 32 * bj + 4 * n);
                if (row < ML) {
                    const int t = row & (T - 1);
                    const float* tab = (fq < 2) ? (ropeR + (t >> 6) * 32) : (ropeC + (t & 63) * 32);
                    tab += 2 * ((fq & 1) * 8);
#pragma unroll
                    for (int n = 0; n < 2; ++n) {
                        const f32x4 t0 = *(const f32x4*)(tab + 8 * n), t1 = *(const f32x4*)(tab + 8 * n + 4);
                        const f32x4 c = {t0[0], t0[2], t1[0], t1[2]}, s = {t0[1], t0[3], t1[1], t1[3]};
                        const f32x4 x1 = y[0][n], x2 = y[1][n];
                        y[0][n] = x1 * c - x2 * s; y[1][n] = x1 * s + x2 * c;
                    }
                }
                bf16_t* rowp = O + (size_t)row * NQ + col0;
#pragma unroll
                for (int bj = 0; bj < 2; ++bj) *(u32x4*)(rowp + 32 * bj) = pk8(y[bj][0], y[bj][1]);
            }
    }
};

struct EpiRes {
    static constexpr bool PERM = false, AFTER_DRAIN = false;
    const float* baseL; const float* baseC; float* out; const float* gate;
    __device__ __forceinline__ void operator()(const f32x4 (&acc)[2][2][4][2], const Unit& u, int wr, int wc, int fr, int fq) const {
        const int row0 = u.pm * BM + wr * 64 + fr, col0 = u.pn * BM + wc * 32 + 4 * fq;
#pragma unroll
        for (int ai = 0; ai < 2; ++ai)
#pragma unroll
            for (int m = 0; m < 4; ++m) {
                const int row = row0 + ai * HALF + m * 16;
                const int bsel = row < ML ? (row >> 11) : 8;
                const float* bp = (row < ML ? baseL + (size_t)row * D : baseC + (size_t)(row - ML) * D) + col0;
                const float* gp = gate + bsel * ADA_LD + col0;
                float* op = out + (size_t)row * D + col0;
#pragma unroll
                for (int bj = 0; bj < 2; ++bj)
#pragma unroll
                    for (int n = 0; n < 2; ++n) { const int o = bj * HALF + n * 16;
                        *(f32x4*)(op + o) = *(const f32x4*)(bp + o) + *(const f32x4*)(gp + o) * acc[ai][bj][m][n]; }
            }
    }
};

__device__ __forceinline__ f32x4 silu_mul(const f32x4 a, const f32x4 b) {
    f32x4 r;
#pragma unroll
    for (int i = 0; i < 4; ++i) r[i] = a[i] * __builtin_amdgcn_rcpf(1.0f + __builtin_amdgcn_exp2f(-LOG2E * a[i])) * b[i];
    return r;
}
struct EpiGated {
    static constexpr bool PERM = true, AFTER_DRAIN = false;
    bf16_t* O; int ldc; int ntile;
    __device__ __forceinline__ void operator()(const f32x4 (&acc)[2][2][4][2], const Unit& u, int wr, int wc, int fr, int fq) const {
        const int row0 = u.pm * BM + wr * 64 + fr, col0 = (u.pn % ntile) * HALF + wc * 32 + 8 * fq;
#pragma unroll
        for (int ai = 0; ai < 2; ++ai)
#pragma unroll
            for (int m = 0; m < 4; ++m) {
                bf16_t* rowp = O + (size_t)(row0 + ai * HALF + m * 16) * ldc + col0;
                *(u32x4*)rowp = pk8(silu_mul(acc[ai][0][m][0], acc[ai][1][m][0]), silu_mul(acc[ai][0][m][1], acc[ai][1][m][1]));
            }
    }
};
struct EpiScatter {
    static constexpr bool PERM = true, AFTER_DRAIN = false;
    bf16_t* Y; const int* rowmap; const float* roww;
    __device__ __forceinline__ void operator()(const f32x4 (&acc)[2][2][4][2], const Unit& u, int wr, int wc, int fr, int fq) const {
        const int row0 = u.pm * BM + wr * 64 + fr, col0 = (u.pn & 3) * BM + wc * 32 + 8 * fq;
#pragma unroll
        for (int ai = 0; ai < 2; ++ai)
#pragma unroll
            for (int m = 0; m < 4; ++m) {
                const int r = row0 + ai * HALF + m * 16; const int ts = rowmap[r];
                if (ts >= 0) { const float w = roww[r]; bf16_t* rowp = Y + (size_t)ts * D + col0;
#pragma unroll
                    for (int bj = 0; bj < 2; ++bj) *(u32x4*)(rowp + bj * HALF) = pk8(acc[ai][bj][m][0] * w, acc[ai][bj][m][1] * w); }
            }
    }
};
struct EpiScatterTail {
    static constexpr bool PERM = true, AFTER_DRAIN = false;
    bf16_t* YT; const float* roww; int kbytes;
    __device__ __forceinline__ void operator()(const f32x4 (&acc)[2][2][4][2], const Unit& u, int wr, int wc, int fr, int fq) const {
        const int row0 = u.pm * BM + wr * 64 + fr, col0 = (u.pn & 3) * BM + wc * 32 + 8 * fq; const int kq = u.ko / kbytes;
#pragma unroll
        for (int ai = 0; ai < 2; ++ai)
#pragma unroll
            for (int m = 0; m < 4; ++m) {
                const int r = row0 + ai * HALF + m * 16; const float w = roww[r]; bf16_t* rowp = YT + ((size_t)kq * 2048 + (r - 64 * 256)) * D + col0;
#pragma unroll
                for (int bj = 0; bj < 2; ++bj) *(u32x4*)(rowp + bj * HALF) = pk8(acc[ai][bj][m][0] * w, acc[ai][bj][m][1] * w);
            }
    }
};
struct MoeOrder {
    const PG8_LAS int* tstart; int nN, G, c, maxpm;
    __device__ __forceinline__ bool next(int i, Unit& u) const {
        const int L = i * G + c; int T = tstart[8]; T = T < maxpm ? T : maxpm;
        const int nb = (T & ~7) * nN; int pm, j;
        if (L < nb) { const int b = L >> 5, r = L & 31, q4 = nN >> 2, g = b / q4; pm = 8 * g + (r & 7); j = 4 * (b - g * q4) + (r >> 3); }
        else { const int L2 = L - nb; pm = (T & ~7) + L2 / nN; j = L2 - (L2 / nN) * nN; }
        if (pm >= T) return false;
        int e = 0;
#pragma unroll
        for (int k = 1; k < 8; ++k) e += (pm >= tstart[k]) ? 1 : 0;
        u.pm = pm; u.pn = e * nN + j; u.ko = 0; return true;
    }
    __device__ __forceinline__ void a_ready(const Unit&) const {}
    __device__ __forceinline__ void done(const Unit&) const {}
};
struct MoeTailOrder {
    const PG8_LAS int* tstart; int c, pm0, kbytes;
    __device__ __forceinline__ bool next(int i, Unit& u) const {
        const int t = c >> 2, pm = pm0 + (t >> 2);
        if (i > 0 || pm >= tstart[8]) return false;
        int e = 0;
#pragma unroll
        for (int k = 1; k < 8; ++k) e += (pm >= tstart[k]) ? 1 : 0;
        u.pm = pm; u.pn = e * 4 + (t & 3); u.ko = (c & 3) * kbytes; return true;
    }
    __device__ __forceinline__ void a_ready(const Unit&) const {}
    __device__ __forceinline__ void done(const Unit&) const {}
};

template <class Epi, class Sched, bool ALIGN_EPI = false, bool SP2 = false>
__device__ __forceinline__ void gemm_phase(PG8_LAS unsigned char* lds, const Gemm g, const Sched& S, const Epi& E) {
    const int tid = threadIdx.x, wid = __builtin_amdgcn_readfirstlane(tid >> 6), lane = tid & 63, wr = wid >> 2, wc = wid & 3, fr = lane & 15, fq = lane >> 4;
    const int K = g.ld, nt = g.K / BK;
    unsigned voffA[2], voffB[2];
#pragma unroll
    for (int i = 0; i < 2; ++i) { int R, C; stage_rc(tid * 16 + i * 8192, R, C); const int Rb = Epi::PERM ? ((R & ~31) + perm32(R & 31)) : R;
        voffA[i] = (unsigned)(R * K + C) * 2u; voffB[i] = (unsigned)(Rb * K + C) * 2u; }
    const size_t kstep = (size_t)(BK * 2);
    const size_t hstep = (size_t)HALF * K * 2;
    const size_t tstep = 2 * hstep;
    const unsigned ldsw = (unsigned)wid * 1024u;
    const int aoff = lds_byte(wr * 64 + fr, fq * 8), boff = lds_byte(wc * 32 + fr, fq * 8);
#define PG8_SA(b, h) (((b) * 2 + (h)) * HTB)
#define PG8_SB(b, h) ((4 + (b) * 2 + (h)) * HTB)
#define PG8_STAGE(bufoff, gbase, voff) do { _Pragma("unroll") for (int _i = 0; _i < 2; ++_i) \
        __builtin_amdgcn_global_load_lds((const unsigned*)((const char*)(gbase) + (voff)[_i]), (PG8_LAS unsigned*)(lds + (bufoff) + ldsw + _i * 8192), 16, 0, 0); } while (0)
#define PG8_LDA(dst, b, h) do { _Pragma("unroll") for (int m = 0; m < 4; ++m) _Pragma("unroll") for (int k = 0; k < 2; ++k) dst[m][k] = *(const PG8_LAS bf16x8*)(lds + PG8_SA(b, h) + aoff + m * 2048 + k * 1024); } while (0)
#define PG8_LDB(dst, b, h) do { _Pragma("unroll") for (int n = 0; n < 2; ++n) _Pragma("unroll") for (int k = 0; k < 2; ++k) dst[n][k] = *(const PG8_LAS bf16x8*)(lds + PG8_SB(b, h) + boff + n * 2048 + k * 1024); } while (0)
#define PG8_MMA(ai, bj, At, Bt) do { __builtin_amdgcn_s_setprio(1); _Pragma("unroll") for (int m = 0; m < 4; ++m) _Pragma("unroll") for (int n = 0; n < 2; ++n) _Pragma("unroll") for (int k = 0; k < 2; ++k) \
        acc[ai][bj][m][n] = __builtin_amdgcn_mfma_f32_16x16x32_bf16(Bt[n][k], At[m][k], acc[ai][bj][m][n], 0, 0, 0); __builtin_amdgcn_s_setprio(0); } while (0)
#define PG8_WAIT_V(n) asm volatile("s_waitcnt vmcnt(" #n ")" ::: "memory")
#define PG8_WAIT_L(n) asm volatile("s_waitcnt lgkmcnt(" #n ")" ::: "memory")
#define PG8_BAR __builtin_amdgcn_s_barrier()
#define PG8_SCHED __builtin_amdgcn_sched_barrier(0)
    Unit cur, nxt; int ui = 0;
    if (!S.next(0, cur)) return;
    f32x4 acc[2][2][4][2];
#pragma unroll
    for (int a = 0; a < 2; ++a)
#pragma unroll
        for (int b = 0; b < 2; ++b)
#pragma unroll
            for (int m = 0; m < 4; ++m)
#pragma unroll
                for (int n = 0; n < 2; ++n) acc[a][b][m][n] = (f32x4){0.f, 0.f, 0.f, 0.f};
    bf16x8 At[4][2], B0[2][2], B1[2][2];
    const char* cA = (const char*)g.A + (size_t)cur.pm * tstep + cur.ko; const char* cB = (const char*)g.Bt + (size_t)cur.pn * tstep + cur.ko;
    S.a_ready(cur);
    if constexpr (SP2) {
        PG8_STAGE(PG8_SB(0, 0), cB, voffB); PG8_STAGE(PG8_SB(0, 1), cB + hstep, voffB); PG8_STAGE(PG8_SA(0, 0), cA, voffA); PG8_STAGE(PG8_SA(0, 1), cA + hstep, voffA);
        if (wr == 1) PG8_BAR;
        PG8_WAIT_V(2); PG8_BAR;
        PG8_STAGE(PG8_SB(1, 0), cB + kstep, voffB); PG8_STAGE(PG8_SA(1, 0), cA + kstep, voffA); PG8_STAGE(PG8_SB(1, 1), cB + hstep + kstep, voffB);
        PG8_WAIT_V(6); PG8_BAR;
    } else {
        PG8_STAGE(PG8_SB(0, 0), cB, voffB); PG8_STAGE(PG8_SA(0, 0), cA, voffA); PG8_STAGE(PG8_SB(0, 1), cB + hstep, voffB); PG8_STAGE(PG8_SA(0, 1), cA + hstep, voffA);
        if (wr == 1) PG8_BAR;
        PG8_WAIT_V(4); PG8_BAR;
        PG8_STAGE(PG8_SB(1, 0), cB + kstep, voffB); PG8_STAGE(PG8_SA(1, 0), cA + kstep, voffA); PG8_STAGE(PG8_SB(1, 1), cB + hstep + kstep, voffB);
        PG8_WAIT_V(6); PG8_BAR;
    }
    for (;;) {
        const bool has_next = S.next(ui + 1, nxt);
        const char* nA = has_next ? (const char*)g.A + (size_t)nxt.pm * tstep + nxt.ko : cA; const char* nB = has_next ? (const char*)g.Bt + (size_t)nxt.pn * tstep + nxt.ko : cB;
        for (int t = 0; t < nt; t += 2) {
            const bool last = (t == nt - 2);
            const char* a1 = cA + (size_t)(t + 1) * kstep;
            const char* a2 = last ? nA : cA + (size_t)(t + 2) * kstep; const char* b2 = last ? nB : cB + (size_t)(t + 2) * kstep;
            const char* a3 = a2 + kstep; const char* b3 = b2 + kstep;
            if (last && has_next) S.a_ready(nxt);
            if constexpr (SP2) {
            PG8_LDB(B0, 0, 0); PG8_LDB(B1, 0, 1); PG8_SCHED; PG8_LDA(At, 0, 0); PG8_STAGE(PG8_SA(1, 1), a1 + hstep, voffA);
            PG8_WAIT_V(8); PG8_WAIT_L(0); PG8_BAR; PG8_MMA(0, 0, At, B0); PG8_MMA(0, 1, At, B1); PG8_BAR; PG8_SCHED;
            PG8_LDA(At, 0, 1); PG8_STAGE(PG8_SB(0, 0), b2, voffB); PG8_STAGE(PG8_SB(0, 1), b2 + hstep, voffB); PG8_STAGE(PG8_SA(0, 0), a2, voffA);
            PG8_WAIT_V(8); PG8_WAIT_L(0); PG8_BAR; PG8_MMA(1, 0, At, B0); PG8_MMA(1, 1, At, B1); PG8_BAR; PG8_SCHED;
            PG8_LDB(B0, 1, 0); PG8_LDB(B1, 1, 1); PG8_SCHED; PG8_LDA(At, 1, 0); PG8_STAGE(PG8_SA(0, 1), a2 + hstep, voffA);
            PG8_WAIT_V(8); PG8_WAIT_L(0); PG8_BAR; PG8_MMA(0, 0, At, B0); PG8_MMA(0, 1, At, B1); PG8_BAR; PG8_SCHED;
            PG8_LDA(At, 1, 1); PG8_STAGE(PG8_SB(1, 0), b3, voffB); PG8_STAGE(PG8_SB(1, 1), b3 + hstep, voffB); PG8_STAGE(PG8_SA(1, 0), a3, voffA);
            PG8_WAIT_V(8); PG8_WAIT_L(0); PG8_BAR; PG8_MMA(1, 0, At, B0); PG8_MMA(1, 1, At, B1); PG8_BAR; PG8_SCHED;
            } else {
            PG8_LDB(B0, 0, 0); PG8_SCHED; PG8_LDA(At, 0, 0); PG8_STAGE(PG8_SA(1, 1), a1 + hstep, voffA);
            PG8_WAIT_L(8); PG8_BAR; PG8_WAIT_L(0); PG8_MMA(0, 0, At, B0); PG8_BAR; PG8_SCHED;
            PG8_LDB(B1, 0, 1); PG8_STAGE(PG8_SB(0, 0), b2, voffB);
            PG8_BAR; PG8_WAIT_L(0); PG8_MMA(0, 1, At, B1); PG8_BAR;
            PG8_LDA(At, 0, 1); PG8_STAGE(PG8_SA(0, 0), a2, voffA);
            PG8_BAR; PG8_WAIT_L(0); PG8_MMA(1, 0, At, B0); PG8_BAR; PG8_SCHED;
            PG8_STAGE(PG8_SB(0, 1), b2 + hstep, voffB);
            PG8_WAIT_V(6); PG8_BAR; PG8_MMA(1, 1, At, B1); PG8_BAR;
            PG8_LDB(B0, 1, 0); PG8_SCHED; PG8_LDA(At, 1, 0); PG8_STAGE(PG8_SA(0, 1), a2 + hstep, voffA);
            PG8_WAIT_L(8); PG8_BAR; PG8_WAIT_L(0); PG8_MMA(0, 0, At, B0); PG8_BAR; PG8_SCHED;
            PG8_LDB(B1, 1, 1); PG8_STAGE(PG8_SB(1, 0), b3, voffB);
            PG8_BAR; PG8_WAIT_L(0); PG8_MMA(0, 1, At, B1); PG8_BAR;
            PG8_LDA(At, 1, 1); PG8_STAGE(PG8_SA(1, 0), a3, voffA);
            PG8_BAR; PG8_WAIT_L(0); PG8_MMA(1, 0, At, B0); PG8_BAR; PG8_SCHED;
            PG8_STAGE(PG8_SB(1, 1), b3 + hstep, voffB);
            PG8_WAIT_V(6); PG8_BAR; PG8_MMA(1, 1, At, B1); PG8_BAR;
            }
        }
        if constexpr (ALIGN_EPI) { if (wr == 0) PG8_BAR; }
        if constexpr (!Epi::AFTER_DRAIN) { E(acc, cur, wr, wc, fr, fq); S.done(cur); }
        if (!has_next) break;
#pragma unroll
        for (int a = 0; a < 2; ++a)
#pragma unroll
            for (int b = 0; b < 2; ++b)
#pragma unroll
                for (int m = 0; m < 4; ++m)
#pragma unroll
                    for (int n = 0; n < 2; ++n) acc[a][b][m][n] = (f32x4){0.f, 0.f, 0.f, 0.f};
        cur = nxt; cA = nA; cB = nB; ++ui;
        if constexpr (ALIGN_EPI) { if (wr == 1) PG8_BAR; }
    }
    PG8_WAIT_V(0);
    if constexpr (!ALIGN_EPI) { if (wr == 0) PG8_BAR; }
    PG8_BAR;
    if constexpr (Epi::AFTER_DRAIN) { E.fused(acc, cur, wr, wc, fr, fq, lds, wid, lane); S.done(cur); }
#undef PG8_SA
#undef PG8_SB
#undef PG8_STAGE
#undef PG8_LDA
#undef PG8_LDB
#undef PG8_MMA
#undef PG8_WAIT_V
#undef PG8_WAIT_L
#undef PG8_BAR
#undef PG8_SCHED
}
}
#ifndef PG8_SP2
#define PG8_SP2 true
#endif
#ifndef PG8_ALIGN
#define PG8_ALIGN true
#endif
#ifndef MK_PER_PHASE
#define MK_PER_PHASE 0
#endif
constexpr size_t MiB = 1u << 20;
constexpr size_t WS_CTL = 0, CTL_ZERO_BYTES = 64 * 1024;
constexpr size_t WS_ADA = 1 * MiB;
constexpr size_t WS_SMALL = 2 * MiB;
constexpr size_t WS_GATES = 4 * MiB;
constexpr size_t WS_SCAN = 6 * MiB;
constexpr size_t WS_WIN = 8 * MiB;
constexpr size_t WS_WOUT = 22 * MiB;
constexpr size_t WS_WUP = 26 * MiB;
constexpr size_t WS_WDN = 37 * MiB;
constexpr size_t WS_MUP = 43 * MiB;
constexpr size_t WS_MDN = 155 * MiB;
constexpr size_t WS_XA = 211 * MiB;
constexpr size_t WS_QKV = 283 * MiB;
constexpr size_t WS_CAT = 409 * MiB;
constexpr size_t WS_H = 445 * MiB;
constexpr size_t WS_DC = 481 * MiB;
constexpr size_t WS_END = 517 * MiB;
constexpr size_t SM_ROPE = 0;
constexpr size_t SM_ROUTE = 16384;
constexpr size_t SM_ROWMAP = SM_ROUTE + (size_t)ML * 32;
constexpr size_t SM_ROWW = SM_ROWMAP + 2 * (size_t)MR * 4;
constexpr size_t SM_AIDX = SM_ROWW + 2 * (size_t)MR * 4;
static_assert(SM_AIDX + 2 * (size_t)MR * 4 <= 2 * MiB, "WS_SMALL map");
constexpr int SC_N = 2 * NB * 4 * TT;
constexpr int SC_ROW = 0, SC_COL = SC_N, SC_LMX = 2 * SC_N, SC_DN = 2 * SC_N + 1024;
constexpr int CW_CNT = 1024;
constexpr int CW_BAR = 4096;
static_assert((CW_BAR + 3456) * 4 <= (int)CTL_ZERO_BYTES, "control words inside the memset region");

constexpr int RING_BYTES = 131072;
constexpr int LDSCTL_OFF = RING_BYTES, MISC_OFF = LDSCTL_OFF + 320;
constexpr int SMALL_OFF = RING_BYTES + 1024;
constexpr int LDS_BYTES = 147456;
constexpr int NWAVES = 8;

#define GAS __attribute__((address_space(1)))
#define LAS __attribute__((address_space(3)))
#define DI __device__ __forceinline__
typedef unsigned short bf16;
typedef float f32x4 __attribute__((ext_vector_type(4)));
typedef float f32x16 __attribute__((ext_vector_type(16)));
typedef short bf16x8 __attribute__((ext_vector_type(8)));
typedef short s16x4 __attribute__((ext_vector_type(4)));
typedef unsigned u32x4 __attribute__((ext_vector_type(4)));
typedef unsigned u32x2 __attribute__((ext_vector_type(2)));
typedef GAS unsigned gu32;
#define RLX_AGENT __ATOMIC_RELAXED, __HIP_MEMORY_SCOPE_AGENT
#define LDS_WAIT() asm volatile("s_waitcnt lgkmcnt(0)" ::: "memory")
using pg8::pk2;
DI float bf2f(unsigned h) { return __uint_as_float(h << 16); }
DI float wave_sum(float v) {
#pragma unroll
    for (int o = 1; o < 64; o <<= 1) v += __shfl_xor(v, o);
    return v;
}
DI float wave_max(float v) {
#pragma unroll
    for (int o = 1; o < 64; o <<= 1) v = fmaxf(v, __shfl_xor(v, o));
    return v;
}

#define XB_TMO      128
#define XB_XCNT(j)  (256  + 64 * (j))
#define XB_XSUB(j)  (1280 + 64 * (j))
#define XB_XGEN(j)  (2304 + 64 * (j))
#define XB_TOP      3328
#define XB_TOPGEN   3392
#define XCD_BAR_WORDS 3456
#define XB_SPIN_CAP (1u << 18)
__device__ __forceinline__ unsigned xb_ld(unsigned* p)              { return __hip_atomic_load(p, __ATOMIC_RELAXED, __HIP_MEMORY_SCOPE_AGENT); }
__device__ __forceinline__ unsigned xb_add(unsigned* p, unsigned v) { return __hip_atomic_fetch_add(p, v, __ATOMIC_RELAXED, __HIP_MEMORY_SCOPE_AGENT); }
__device__ __forceinline__ unsigned xb_xcc_id() { return (unsigned)__builtin_amdgcn_s_getreg((3 << 11) | 20) & 0xFu; }
#define XB_SPIN(cond, bar) do { unsigned _sp = 0; while (cond) { __builtin_amdgcn_s_sleep(1); \
    if ((++_sp & 255u) == 0u) { if (xb_ld(&(bar)[XB_TMO])) break; if (_sp > XB_SPIN_CAP) { atomicAdd(&(bar)[XB_TMO], 1u); break; } } } } while (0)
struct XcdBarrier { unsigned* bar; unsigned x; volatile LAS unsigned* st; };
__device__ __forceinline__ XcdBarrier xcd_barrier_post(unsigned* bar, volatile LAS unsigned* st) {
    XcdBarrier b; b.bar = bar; b.x = xb_xcc_id(); b.st = st;
    if (threadIdx.x == 0) (void)xb_add(&bar[XB_XCNT(b.x)], 1u);
    return b;
}
__device__ __forceinline__ void xcd_barrier_complete(unsigned* bar, unsigned x, unsigned& nloc, unsigned& nx) {
    const unsigned G = gridDim.x * gridDim.y * gridDim.z;
    unsigned sum, cnt, mine, sp = 0u;
    for (;;) {
        sum = 0u; cnt = 0u; mine = 0u;
#pragma unroll
        for (unsigned j = 0; j < 16; ++j) { const unsigned c = xb_ld(&bar[XB_XCNT(j)]); sum += c; cnt += (c > 0u) ? 1u : 0u; mine = (j == x) ? c : mine; }
        if (sum == G) break;
        __builtin_amdgcn_s_sleep(1);
        if ((++sp & 255u) == 0u) { if (xb_ld(&bar[XB_TMO])) break; if (sp > XB_SPIN_CAP) { atomicAdd(&bar[XB_TMO], 1u); break; } }
    }
    nloc = mine > 0u ? mine : 1u; nx = cnt > 0u ? cnt : 1u;
}
__device__ __forceinline__ void xcd_barrier(const XcdBarrier& b) {
    asm volatile("s_waitcnt vmcnt(0)" ::: "memory");
    __syncthreads();
    if (threadIdx.x == 0) {
        unsigned* bar = b.bar;
        __builtin_amdgcn_s_waitcnt(0);
        unsigned nloc = b.st[0], nx = b.st[1];
        if (nloc == 0u) { xcd_barrier_complete(bar, b.x, nloc, nx); b.st[0] = nloc; b.st[1] = nx; }
        const unsigned old = xb_add(&bar[XB_XSUB(b.x)], 1u);
        const unsigned gen = old / nloc;
        if (old + 1u == (gen + 1u) * nloc) {
            __builtin_amdgcn_fence(__ATOMIC_RELEASE, "agent");
            asm volatile("s_waitcnt vmcnt(0)" ::: "memory");
            const unsigned og = xb_add(&bar[XB_TOP], 1u);
            const unsigned tg = og / nx;
            if (og + 1u == (tg + 1u) * nx) xb_add(&bar[XB_TOPGEN], 1u);
            else XB_SPIN(xb_ld(&bar[XB_TOPGEN]) == tg, bar);
            __builtin_amdgcn_fence(__ATOMIC_ACQUIRE, "agent");
            xb_add(&bar[XB_XGEN(b.x)], 1u);
            asm volatile("s_waitcnt vmcnt(0)" ::: "memory");
        } else {
            XB_SPIN(xb_ld(&bar[XB_XGEN(b.x)]) == gen, bar);
            __builtin_amdgcn_fence(__ATOMIC_ACQUIRE, "agent");
            asm volatile("s_waitcnt vmcnt(0)" ::: "memory");
        }
    }
    __syncthreads();
}

struct Args { const float* in[28]; float* out; unsigned char* ws; int ph_lo, ph_hi; };
typedef const Args __attribute__((address_space(4)))* KArgs;
DI KArgs kargs() { KArgs p = (KArgs)__builtin_amdgcn_kernarg_segment_ptr(); asm volatile("" : "+s"(p)); return p; }
struct Frame {
    LAS unsigned char* lds;
    int tid, lane, wave, vcu, G;
};
DI Frame fresh(const Frame& F0) { Frame F = F0; int l = (int)__builtin_amdgcn_mbcnt_hi(~0u, __builtin_amdgcn_mbcnt_lo(~0u, 0u)); asm volatile("" : "+v"(l)); F.lane = l; F.tid = F.wave * 64 + l; return F; }
enum { I_X = 0, I_C, I_CTX, I_CCTX, I_ADAW, I_ADAB, I_N1G, I_N2G, I_WIN, I_WOUT, I_QNG, I_KNG, I_LQ1, I_LK1, I_LQ2, I_LK2, I_SUBLN, I_CONVW, I_CONVB, I_GATEB, I_MNG,
       I_FW1, I_FW3, I_FW2, I_RW, I_MW1, I_MW3, I_MW2 };

template <bool NT = false>
DI void tr_item(const float* W, int ldw, int K, bf16* WT, int k0, int n0, int drow0, LAS float* scr, int lane) {
#pragma unroll 8
    for (int i = 0; i < 32; ++i) { const int kk = 2 * i + (lane >> 5); const float* src = &W[(size_t)(k0 + kk) * ldw + n0 + (lane & 31)]; scr[kk * 33 + (lane & 31)] = NT ? __builtin_nontemporal_load(src) : *src; }
    LDS_WAIT(); asm volatile("" ::: "memory");
    const int c = lane & 7;
#pragma unroll
    for (int j = 0; j < 4; ++j) { const int n = (lane >> 3) + 8 * j; const LAS float* s = scr + (8 * c) * 33 + n;
        u32x4 o; o.x = pk2(s[0 * 33], s[1 * 33]); o.y = pk2(s[2 * 33], s[3 * 33]); o.z = pk2(s[4 * 33], s[5 * 33]); o.w = pk2(s[6 * 33], s[7 * 33]);
        u32x4* dst = (u32x4*)(WT + (size_t)(drow0 + n) * K + k0 + 8 * c);
        if (NT) __builtin_nontemporal_store(o, dst); else *dst = o; }
    LDS_WAIT(); asm volatile("" ::: "memory");
}
DI int map_win(int n0) {
    if (n0 >= 1024) return n0;
    const int pn = n0 >> 8, o = n0 & 255, g = o >> 6, d = o & 63;
    return (pn << 8) + 128 * (d >> 5) + 32 * g;
}
DI int map_up(int n0, int third) { return 256 * (n0 >> 7) + 128 * third + (n0 & 127); }
constexpr int CV_IN = 16 * 112, CV_OUT = 16 * 32, CV_UP = 16 * 88, CV_DN = 44 * 32, CV_M13 = 16 * 112, CV_M2 = 56 * 32;
constexpr int CV_PRO = 2 * CV_IN + 2 * CV_OUT + 2 * CV_UP + CV_DN + 8300, CV_P4 = CV_PRO + 7500, CV_P6 = CV_P4 + 8400;
constexpr int CV_SMALL = 2 * CV_IN + 2 * CV_OUT + 2 * CV_UP + CV_DN, CV_ALL = CV_SMALL + 16 * CV_M13 + 8 * CV_M2;
DI void cvt_item(const KArgs ka, int it, LAS float* scr, int lane) {
    unsigned char* ws = ka->ws;
    int r = it;
    if (r < 2 * CV_IN) { const int l = r / CV_IN; r -= l * CV_IN; const int kb = r / 112, nb = r % 112;
        tr_item(ka->in[I_WIN] + (size_t)l * 1024 * INC, INC, 1024, (bf16*)(ws + WS_WIN) + (size_t)l * NQ * 1024, 64 * kb, 32 * nb, map_win(32 * nb), scr, lane); return; } r -= 2 * CV_IN;
    if (r < 2 * CV_OUT) { const int l = r / CV_OUT; r -= l * CV_OUT; const int kb = r / 32, nb = r % 32;
        tr_item(ka->in[I_WOUT] + (size_t)l * 1024 * 1024, 1024, 1024, (bf16*)(ws + WS_WOUT) + (size_t)l * 1024 * 1024, 64 * kb, 32 * nb, 32 * nb, scr, lane); return; } r -= 2 * CV_OUT;
    if (r < 2 * CV_UP) { const int th = r / CV_UP; r -= th * CV_UP; const int kb = r / 88, nb = r % 88;
        tr_item(ka->in[th ? I_FW3 : I_FW1], FF, 1024, (bf16*)(ws + WS_WUP), 64 * kb, 32 * nb, map_up(32 * nb, th), scr, lane); return; } r -= 2 * CV_UP;
    if (r < CV_DN) { const int kb = r / 32, nb = r % 32;
        tr_item(ka->in[I_FW2], 1024, FF, (bf16*)(ws + WS_WDN), 64 * kb, 32 * nb, 32 * nb, scr, lane); return; } r -= CV_DN;
    if (r < 16 * CV_M13) { const int th = r / (8 * CV_M13); r -= th * 8 * CV_M13; const int e = r / CV_M13; r -= e * CV_M13; const int kb = r / 112, nb = r % 112;
        tr_item<true>(ka->in[th ? I_MW3 : I_MW1] + (size_t)e * 1024 * FFE, FFE, 1024, (bf16*)(ws + WS_MUP), 64 * kb, 32 * nb, e * 2 * FFE + map_up(32 * nb, th), scr, lane); return; } r -= 16 * CV_M13;
    { const int e = r / CV_M2; r -= e * CV_M2; const int kb = r / 32, nb = r % 32;
        tr_item<true>(ka->in[I_MW2] + (size_t)e * FFE * 1024, 1024, FFE, (bf16*)(ws + WS_MDN), 64 * kb, 32 * nb, e * 1024 + 32 * nb, scr, lane); }
}
DI void p0_prologue(const Frame& F) {
    const KArgs ka = kargs(); unsigned char* ws = ka->ws;
    {
        LAS float* S = (LAS float*)F.lds;
        LAS float* P = (LAS float*)(F.lds + 36864);
        bool have = false;
        for (int it = F.vcu; it < 192; it += F.G) {
            if (!have) {
                for (int idx = F.tid; idx < 9 * 1024; idx += NWAVES * 64) { const int r = idx >> 10, i = idx & 1023; const float v = r < 8 ? ka->in[I_C][r * 1024 + i] : ka->in[I_CCTX][i]; S[idx] = v / (1.0f + expf(-v)); }
                __syncthreads(); have = true;
            }
            const int l = it / 96, col = (it % 96) * 64 + F.lane;
            const float* w = ka->in[I_ADAW] + (size_t)l * 1024 * ADA_LD + col;
            float acc[9];
#pragma unroll
            for (int r = 0; r < 9; ++r) acc[r] = 0.f;
            const int kb = F.wave * 128;
#pragma unroll 4
            for (int k = 0; k < 128; ++k) { const float wv = w[(size_t)(kb + k) * ADA_LD];
#pragma unroll
                for (int r = 0; r < 9; ++r) acc[r] += S[r * 1024 + kb + k] * wv; }
#pragma unroll
            for (int r = 0; r < 9; ++r) P[(F.wave * 9 + r) * 64 + F.lane] = acc[r];
            __syncthreads();
            for (int idx = F.tid; idx < 9 * 64; idx += NWAVES * 64) { const int r = idx >> 6, ln = idx & 63; float s = 0.f;
#pragma unroll
                for (int w8 = 0; w8 < 8; ++w8) s += P[(w8 * 9 + r) * 64 + ln];
                const int c2 = (it % 96) * 64 + ln;
                ((float*)(ws + WS_ADA))[l * ADA_L + r * ADA_LD + c2] = s + ka->in[I_ADAB][l * ADA_LD + c2]; }
            __syncthreads();
        }
        __syncthreads();
    }
    if (F.vcu == 0) {
        float* rr = (float*)(ws + WS_SMALL + SM_ROPE);
        for (int idx = F.tid; idx < 96 * 16; idx += NWAVES * 64) { const int p = idx >> 4, i = idx & 15;
            const float inv = exp2f(-(float)i * (13.287712379549449f / 16.0f)); const float pos = (float)(p < 32 ? p : p - 32); const float ang = pos * inv;
            rr[p * 32 + 2 * i] = cosf(ang); rr[p * 32 + 2 * i + 1] = sinf(ang); }
    }
    LAS float* scr = (LAS float*)(F.lds + F.wave * 16384);
    const int gw = F.vcu * NWAVES + F.wave, NGW = F.G * NWAVES;
    for (int it = gw; it < CV_PRO; it += NGW) cvt_item(ka, it, scr, F.lane);
}
DI void idle_convert(const Frame& F, int nunits, int lo, int hi) {
    const int r = nunits % F.G, c = (int)blockIdx.x;
    if (r == 0 || c < r) return;
    const KArgs ka = kargs();
    LAS float* scr = (LAS float*)(F.lds + F.wave * 16384);
    const int gw = (c - r) * NWAVES + F.wave, NGW = (F.G - r) * NWAVES;
    for (int it = lo + gw; it < hi; it += NGW) cvt_item(ka, it, scr, F.lane);
}
template <int KIND>
DI void modulate_phase(const Frame& F, const float* srcL, const float* srcC, int nrows, const float* gam, const float* ada  , int off_sh, int off_sc,
                       bf16* H, const float* wtab  , float* gates, unsigned char* ws) {
    constexpr int NT = KIND == 0 ? 16 : (KIND == 2 ? 8 : 0);
    LAS float* tab = (LAS float*)F.lds;
    if (NT) {
        for (int idx = F.tid; idx < NT * 1024; idx += NWAVES * 64) { const int k = idx / NT, g = idx % NT;
            tab[g * 1024 + k] = KIND == 0 ? wtab[(size_t)k * INC + NQ + g] : wtab[k * NE + g]; }
        __syncthreads();
    }
    const int gw = F.vcu * NWAVES + F.wave, NGW = F.G * NWAVES;
    LAS unsigned* lc = (LAS unsigned*)(F.lds + SMALL_OFF + 256);
    LAS unsigned* rl = (LAS unsigned*)(F.lds + SMALL_OFF + 512);
    if (KIND == 2) { int t_ = F.tid; asm volatile("" : "+v"(t_)); if (t_ < 32) lc[t_] = 0u; __syncthreads(); }
    int kk = 0;
    f32x4 nxt[4];
#define MOD_LOAD(r_) do { const int r2_ = (r_) < nrows ? (r_) : gw; const float* xr_ = (r2_ < ML ? srcL + (size_t)r2_ * D : srcC + (size_t)(r2_ - ML) * D) + 4 * F.lane; \
        _Pragma("unroll") for (int j = 0; j < 4; ++j) nxt[j] = *(const f32x4*)(xr_ + 256 * j); } while (0)
    if (gw < nrows) MOD_LOAD(gw);
    for (int row = gw; row < nrows; row += NGW, ++kk) {
        const int bsel = row < ML ? (row >> 11) : 8;
        const float* sh = ada + bsel * ADA_LD + off_sh + 4 * F.lane; const float* sc = ada + bsel * ADA_LD + off_sc + 4 * F.lane; const float* gm = gam + 4 * F.lane;
        f32x4 v[4]; float ss = 0.f;
#pragma unroll
        for (int j = 0; j < 4; ++j) { v[j] = nxt[j]; ss += (v[j][0] * v[j][0] + v[j][1] * v[j][1]) + (v[j][2] * v[j][2] + v[j][3] * v[j][3]); }
        MOD_LOAD(row + NGW);
        const float rstd = 1.0f / sqrtf(wave_sum(ss) * (1.0f / D) + EPS);
#pragma unroll
        for (int j = 0; j < 4; ++j) { const f32x4 g4 = *(const f32x4*)(gm + 256 * j), s4 = *(const f32x4*)(sc + 256 * j), h4 = *(const f32x4*)(sh + 256 * j);
            v[j] = v[j] * rstd * g4 * (s4 + 1.0f) + h4; }
        u32x2* o8 = (u32x2*)(H + (size_t)row * D) + F.lane;
#pragma unroll
        for (int j = 0; j < 4; ++j) { u32x2 w; w.x = pk2(v[j][0], v[j][1]); w.y = pk2(v[j][2], v[j][3]); o8[64 * j] = w; }
        if (NT) {
            float part[NT > 0 ? NT : 1];
#pragma unroll
            for (int g = 0; g < NT; ++g) { float s = 0.f;
#pragma unroll
                for (int j = 0; j < 4; ++j) { const f32x4 w4 = *(const LAS f32x4*)(tab + g * 1024 + 4 * F.lane + 256 * j); s += (v[j][0] * w4[0] + v[j][1] * w4[1]) + (v[j][2] * w4[2] + v[j][3] * w4[3]); }
                part[g] = s;
                if ((g & 3) == 3) asm volatile("" : "+v"(part[g - 3]), "+v"(part[g - 2]), "+v"(part[g - 1]), "+v"(part[g])); }
            int nv = NT, sh_ = 32;
#pragma unroll
            for (int st = 0; st < (NT == 16 ? 4 : 3); ++st) {
                const bool up = (F.lane & sh_) != 0; nv >>= 1;
#pragma unroll
                for (int g = 0; g < nv; ++g) { const float keep = up ? part[g + nv] : part[g], give = up ? part[g] : part[g + nv]; part[g] = keep + __shfl_xor(give, sh_); }
                sh_ >>= 1;
            }
            float mine = part[0];
#pragma unroll
            for (int o = (NT == 16 ? 2 : 4); o >= 1; o >>= 1) mine += __shfl_xor(mine, o);
            if (KIND == 0) {
                const int gidx = ((F.lane >> 5) & 1) * 8 + ((F.lane >> 4) & 1) * 4 + ((F.lane >> 3) & 1) * 2 + ((F.lane >> 2) & 1);
                if ((F.lane & 3) == 0) gates[(size_t)row * 16 + gidx] = mine;
            } else {
                const int eidx = ((F.lane >> 5) & 1) * 4 + ((F.lane >> 4) & 1) * 2 + ((F.lane >> 3) & 1);
                float v0 = mine; int i0 = eidx;
#pragma unroll
                for (int o = 8; o < 64; o <<= 1) { const float ov = __shfl_xor(v0, o); const int oi = __shfl_xor(i0, o); if (ov > v0 || (ov == v0 && oi < i0)) { v0 = ov; i0 = oi; } }
                float v1 = (eidx == i0) ? -INFINITY : mine; int i1 = eidx;
#pragma unroll
                for (int o = 8; o < 64; o <<= 1) { const float ov = __shfl_xor(v1, o); const int oi = __shfl_xor(i1, o); if (ov > v1 || (ov == v1 && oi < i1)) { v1 = ov; i1 = oi; } }
                if (F.lane == 0) {
                    const float w0 = 1.0f / (1.0f + expf(v1 - v0)), w1 = 1.0f - w0;
                    const int half = row >> 13;
                    unsigned p0, p1;
                    if (kk < 16) { p0 = __hip_atomic_fetch_add(lc + half * 8 + i0, 1u, __ATOMIC_RELAXED, __HIP_MEMORY_SCOPE_WORKGROUP); p1 = __hip_atomic_fetch_add(lc + half * 8 + i1, 1u, __ATOMIC_RELAXED, __HIP_MEMORY_SCOPE_WORKGROUP);
                        LAS unsigned* r = rl + (F.wave * 16 + kk) * 8; r[0] = (unsigned)i0; r[1] = (unsigned)i1; r[2] = p0; r[3] = p1; r[4] = __float_as_uint(w0); r[5] = __float_as_uint(w1); }
                    else { unsigned* cnt = (unsigned*)(ws + WS_CTL) + CW_CNT + half * 8; p0 = atomicAdd(cnt + i0, 1u); p1 = atomicAdd(cnt + i1, 1u);
                        u32x4* rec = (u32x4*)(ws + WS_SMALL + SM_ROUTE + (size_t)row * 32);
                        rec[0] = (u32x4){(unsigned)i0, (unsigned)i1, p0, p1}; rec[1] = (u32x4){__float_as_uint(w0), __float_as_uint(w1), 0u, 0u}; }
                }
            }
        }
    }
#undef MOD_LOAD
    if (KIND == 2) {
        __syncthreads();
        if (F.tid < 16) lc[16 + F.tid] = atomicAdd((unsigned*)(ws + WS_CTL) + CW_CNT + F.tid, lc[F.tid]);
        __syncthreads();
        if (F.lane == 0) { int k2 = 0;
            for (int row = gw; row < nrows && k2 < 16; row += NGW, ++k2) { const LAS unsigned* r = rl + (F.wave * 16 + k2) * 8; const int half = row >> 13;
                u32x4* rec = (u32x4*)(ws + WS_SMALL + SM_ROUTE + (size_t)row * 32);
                rec[0] = (u32x4){r[0], r[1], r[2] + lc[16 + half * 8 + r[0]], r[3] + lc[16 + half * 8 + r[1]]}; rec[1] = (u32x4){r[4], r[5], 0u, 0u}; } }
    }
}

DI void conv_phase(const Frame& F, const bf16* QKV, bf16* MQK, const float* cw, const float* cb) {
    const int tg = F.tid >> 6, cg = F.tid & 63;
    for (int it = F.vcu; it < 2 * (MR / 64); it += F.G) {
        const int c0 = (it & 1) * 512 + 8 * cg;
        const int r0 = (it >> 1) * 64 + tg * 8;
        const int seqlen = r0 < ML ? T : CT, sbase = r0 < ML ? (r0 & ~(T - 1)) : ML + ((r0 - ML) & ~(CT - 1));
        const int t0 = r0 - sbase;
        u32x4 raw[12];
#pragma unroll
        for (int j = 0; j < 12; ++j) { const int t = t0 - 2 + j; raw[j] = (u32x4){0u, 0u, 0u, 0u};
            if (t >= 0 && t < seqlen) raw[j] = *(const u32x4*)(QKV + (size_t)(sbase + t) * NQ + 1536 + c0); }
        const float osc = c0 >= 512 ? 0.08838834764831845f : 1.0f;
        float acc[8][8];
        { const f32x4 a = *(const f32x4*)(cb + c0), b = *(const f32x4*)(cb + c0 + 4);
#pragma unroll
          for (int k = 0; k < 8; ++k)
#pragma unroll
              for (int i = 0; i < 4; ++i) { acc[k][i] = a[i]; acc[k][4 + i] = b[i]; } }
#pragma unroll
        for (int j = 0; j < 5; ++j) {
            const f32x4 wa = *(const f32x4*)(cw + j * 1024 + c0), wb = *(const f32x4*)(cw + j * 1024 + c0 + 4);
#pragma unroll
            for (int k = 0; k < 8; ++k) { const u32x4 r = raw[k + j];
#pragma unroll
                for (int i = 0; i < 4; ++i) { const float wl = i < 2 ? wa[2 * i] : wb[2 * i - 4], wh = i < 2 ? wa[2 * i + 1] : wb[2 * i - 3];
                    acc[k][2 * i] += wl * bf2f(r[i] & 0xffffu); acc[k][2 * i + 1] += wh * bf2f(r[i] >> 16); } }
        }
#pragma unroll
        for (int k = 0; k < 8; ++k) { float y[8];
#pragma unroll
            for (int i = 0; i < 8; ++i) { const float sv = acc[k][i]; y[i] = sv * __builtin_amdgcn_rcpf(1.0f + __builtin_amdgcn_exp2f(-LOG2E * sv)) * osc; }
            u32x4 o; o.x = pk2(y[0], y[1]); o.y = pk2(y[2], y[3]); o.z = pk2(y[4], y[5]); o.w = pk2(y[6], y[7]);
            *(u32x4*)(MQK + (size_t)(r0 + k) * D + c0) = o; }
    }
}
DI float log_sigmoid(float g) { return fminf(g, 0.f) - log1pf(expf(-fabsf(g))); }
DI void scan_phase(const Frame& F, const float* gates, const float* gb  , float* scan) {
    LAS float* xs = (LAS float*)(F.lds + SMALL_OFF + 512);
    const int hw = F.wave >> 2, w4 = F.wave & 3, t256 = F.tid & 255;
    for (int it = F.vcu; it < 32; it += F.G) {
        const int ch = 2 * it + hw;
        const int dir = ch >> 5, b = (ch >> 2) & 7, h = ch & 3;
        const float bi = gb[dir * 8 + h], bf_ = gb[dir * 8 + 4 + h];
        const int gi = dir * 8 + h, gf = dir * 8 + 4 + h;
        float li[9], lf[9]; float tot = 0.f, lmx = 0.f;
#pragma unroll
        for (int k = 0; k < 9; ++k) { const int p = 9 * t256 + k;
            int row; if (dir == 0) row = p < CT ? ML + b * CT + p : b * T + (p - CT); else row = p < T ? b * T + p : ML + b * CT + (p - T);
            li[k] = gates[(size_t)row * 16 + gi] + bi; lf[k] = gates[(size_t)row * 16 + gf] + bf_; }
#pragma unroll
        for (int k = 0; k < 9; ++k) { lf[k] = log_sigmoid(lf[k]); tot += lf[k]; lmx = fmaxf(lmx, li[k]); }
        lmx = wave_max(lmx);
        float incl = tot;
#pragma unroll
        for (int o = 1; o < 64; o <<= 1) { const float n = __shfl_up(incl, o); if (F.lane >= o) incl += n; }
        if (F.lane == 63) xs[(hw * 4 + w4) * 2] = incl;
        if (F.lane == 0) xs[(hw * 4 + w4) * 2 + 1] = lmx;
        __syncthreads();
        float run = incl - tot;
#pragma unroll
        for (int w = 0; w < 4; ++w) { if (w < w4) run += xs[(hw * 4 + w) * 2]; lmx = fmaxf(lmx, xs[(hw * 4 + w) * 2 + 1]); }
        float* ROW = scan + SC_ROW + (size_t)ch * TT; float* COL = scan + SC_COL + (size_t)ch * TT;
#pragma unroll
        for (int k = 0; k < 9; ++k) { const int p = 9 * t256 + k;
            const int u = dir == 0 ? p : (p < T ? CT + p : p - T);
            if (dir == 0) { run += lf[k]; ROW[u] = run * LOG2E; COL[u] = (run - li[k] + lmx) * LOG2E; }
            else { ROW[u] = -run * LOG2E; COL[u] = (-run - li[k] + lmx) * LOG2E; run += lf[k]; } }
        if (t256 == 0) scan[SC_LMX + ch] = lmx;
        __syncthreads();
    }
}

DI s16x4 vtr_(const LAS unsigned char* p) { typedef short v4i16_t __attribute__((ext_vector_type(4))); return __builtin_bit_cast(s16x4, __builtin_amdgcn_ds_read_tr16_b64_v4i16((LAS v4i16_t*)p)); }
DI void mstate_unit(const Frame& F, const bf16* QKV, const float* scan, const float* cw  , const float* cb, float* DC, int b, int h, int k) {
    const int tid = F.tid, lane = F.lane, wid = F.wave, hi = lane >> 5;
    LAS unsigned char* lds = F.lds;
    const int c16 = tid & 15, tgrp = tid >> 4;
    const int ch0 = h * 128 + 8 * c16;
    const int seqrow0 = k == 0 ? ML + b * CT : b * T, seqlen = k == 0 ? CT : T, tchunk = k == 0 ? 0 : 256 * (k - 1);
    const int chF = b * 4 + h, chB = 32 + b * 4 + h;
    const float refF = scan[SC_ROW + (size_t)chF * TT + 256 * k + 255], refB = scan[SC_ROW + (size_t)chB * TT + 256 * k];
    const float* cwk = cw + 512 + ch0; const float* cbk = cb + 512 + ch0;
    const int dir = wid >> 2, dkb = wid & 3;
    f32x16 acc[5];
#pragma unroll
    for (int d = 0; d < 5; ++d)
#pragma unroll
        for (int i = 0; i < 16; ++i) acc[d][i] = 0.f;
    const unsigned vbn = ((lane >> 4) & 1) * 32 + (lane & 3) * 8 + (8 * hi + ((lane & 15) >> 2)) * 64;
#pragma unroll 1
    for (int sub = 0; sub < 2; ++sub) {
        const int tl0 = 128 * sub + 4 * tgrp;
#pragma unroll 2
        for (int q = 0; q < 4; ++q) {
            const int tl = tl0 + q;
            float y[8];
            { const f32x4 a = *(const f32x4*)cbk, c = *(const f32x4*)(cbk + 4);
#pragma unroll
              for (int i = 0; i < 4; ++i) { y[i] = a[i]; y[4 + i] = c[i]; } }
#pragma unroll
            for (int j = 0; j < 5; ++j) { const int t = tchunk + tl - 2 + j; u32x4 rw4 = (u32x4){0u, 0u, 0u, 0u};
                if (t >= 0 && t < seqlen) rw4 = *(const u32x4*)(QKV + (size_t)(seqrow0 + t) * NQ + 2048 + ch0);
                const f32x4 wa = *(const f32x4*)(cwk + j * 1024), wb = *(const f32x4*)(cwk + j * 1024 + 4);
#pragma unroll
                for (int i = 0; i < 8; ++i) { const unsigned rw = rw4[i >> 1]; y[i] += (i < 4 ? wa[i] : wb[i - 4]) * bf2f((i & 1) ? (rw >> 16) : (rw & 0xffffu)); } }
#pragma unroll
            for (int i = 0; i < 8; ++i) { const float sv = y[i]; y[i] = sv * __builtin_amdgcn_rcpf(1.0f + __builtin_amdgcn_exp2f(-LOG2E * sv)) * 0.08838834764831845f; }
            const float uf = __builtin_amdgcn_exp2f(refF - scan[SC_COL + (size_t)chF * TT + 256 * k + tl]), ub = __builtin_amdgcn_exp2f(refB - scan[SC_COL + (size_t)chB * TT + 256 * k + tl]);
            u32x4 of, ob;
#pragma unroll
            for (int i = 0; i < 4; ++i) { of[i] = pk2(y[2 * i] * uf, y[2 * i + 1] * uf); ob[i] = pk2(y[2 * i] * ub, y[2 * i + 1] * ub); }
            const unsigned ka = (c16 >> 2) * 8192 + (4 * tgrp + q) * 64 + (c16 & 3) * 16;
            *(LAS u32x4*)(lds + ka) = of; *(LAS u32x4*)(lds + 32768 + ka) = ob;
            const u32x4 vv = *(const u32x4*)(QKV + (size_t)(seqrow0 + tchunk + tl) * NQ + 2560 + ch0);
            *(LAS u32x4*)(lds + 65536 + ka) = vv;
        }
        { const int tok = tid >> 2, pc = tid & 3;
          *(LAS u32x4*)(lds + 65536 + 4 * 8192 + tok * 64 + pc * 16) = (u32x4){pc == 0 ? 0x3F80u : 0u, 0u, 0u, 0u}; }
        __syncthreads();
        const LAS unsigned char* Kb_ = lds + dir * 32768 + dkb * 8192 + vbn; const LAS unsigned char* Vb_ = lds + 65536 + vbn;
#pragma unroll 2
        for (int ks = 0; ks < 8; ++ks) {
            const s16x4 al = vtr_(Kb_ + ks * 1024), ah = vtr_(Kb_ + ks * 1024 + 256);
            const bf16x8 af = (bf16x8){al[0], al[1], al[2], al[3], ah[0], ah[1], ah[2], ah[3]};
#pragma unroll
            for (int d = 0; d < 5; ++d) { const s16x4 bl = vtr_(Vb_ + d * 8192 + ks * 1024), bh = vtr_(Vb_ + d * 8192 + ks * 1024 + 256);
                acc[d] = __builtin_amdgcn_mfma_f32_32x32x16_bf16(af, (bf16x8){bl[0], bl[1], bl[2], bl[3], bh[0], bh[1], bh[2], bh[3]}, acc[d], 0, 0, 0); }
        }
        __syncthreads();
    }
    const int r32 = lane & 31;
    float* dc = DC + ((size_t)((dir * 32 + b * 4 + h) * 9 + k) << 14);
    float* dn = (float*)scan + SC_DN + ((dir * 32 + b * 4 + h) * 9 + k) * 128;
#pragma unroll
    for (int i = 0; i < 16; ++i) { const int dk = 32 * dkb + (i & 3) + 8 * (i >> 2) + 4 * hi;
#pragma unroll
        for (int d = 0; d < 4; ++d) dc[dk * 128 + 32 * d + r32] = acc[d][i];
        if (r32 == 0) dn[dk] = acc[4][i]; }
}
DI void mprefix_phase(const Frame& F, float* scan, float* DC) {
    for (int it = F.vcu; it < 256; it += F.G) {
        const int ch = it >> 2, part = it & 3, dir = ch >> 5;
        const float* ROW = scan + SC_ROW + (size_t)ch * TT;
        float* base = DC + ((size_t)(ch * 9) << 14) + part * 4096 + F.tid * 8;
        float* nb = scan + SC_DN + ch * 9 * 128 + (F.tid & 127);
        const bool don = part == 0 && F.tid < 128;
        f32x4 x0[9], x1[9]; float xn[9], G[9];
#pragma unroll
        for (int k = 0; k < 9; ++k) { const float* p = base + ((size_t)k << 14); x0[k] = *(const f32x4*)p; x1[k] = *(const f32x4*)(p + 4); xn[k] = don ? nb[k * 128] : 0.f; }
        if (dir == 0) {
#pragma unroll
            for (int k = 1; k < 8; ++k) G[k] = __builtin_amdgcn_exp2f(ROW[256 * k + 255] - ROW[256 * k - 1]);
#pragma unroll
            for (int k = 1; k < 8; ++k) { x0[k] = x0[k - 1] * G[k] + x0[k]; x1[k] = x1[k - 1] * G[k] + x1[k]; xn[k] = xn[k - 1] * G[k] + xn[k];
                float* p = base + ((size_t)k << 14); *(f32x4*)p = x0[k]; *(f32x4*)(p + 4) = x1[k]; if (don) nb[k * 128] = xn[k]; }
        } else {
#pragma unroll
            for (int k = 2; k < 9; ++k) G[k] = __builtin_amdgcn_exp2f(ROW[256 * k] - ROW[256 * (k == 8 ? 0 : k + 1)]);
#pragma unroll
            for (int k = 8; k >= 2; --k) { const int nx = k == 8 ? 0 : k + 1;
                x0[k] = x0[nx] * G[k] + x0[k]; x1[k] = x1[nx] * G[k] + x1[k]; xn[k] = xn[nx] * G[k] + xn[k];
                float* p = base + ((size_t)k << 14); *(f32x4*)p = x0[k]; *(f32x4*)(p + 4) = x1[k]; if (don) nb[k * 128] = xn[k]; }
        }
    }
}
DI int crow(int r, int hi) { return (r & 3) + 8 * (r >> 2) + 4 * hi; }
DI s16x4 vtr(const LAS unsigned char* p) { typedef short v4i16_t __attribute__((ext_vector_type(4))); return __builtin_bit_cast(s16x4, __builtin_amdgcn_ds_read_tr16_b64_v4i16((LAS v4i16_t*)p)); }
DI bf16x8 pack8(const f32x16& x, int s) {
    u32x4 p; p.x = pk2(x[8 * s], x[8 * s + 1]); p.y = pk2(x[8 * s + 2], x[8 * s + 3]); p.z = pk2(x[8 * s + 4], x[8 * s + 5]); p.w = pk2(x[8 * s + 6], x[8 * s + 7]);
    return __builtin_bit_cast(bf16x8, p);
}
struct MixArgs {
    const bf16* QKV; const bf16* MQK; bf16* CAT; const float* scan; const float* DC;
    const float* gain;
    float lam, post, negm;
};
template <int MODE>
DI void mix_unit(const Frame& F, const MixArgs& A, int b, int h, int qt, bool isctx) {
    constexpr int KS = MODE == 0 ? 4 : 8;
    const int tid = F.tid, lane = F.lane, wid = F.wave, r32 = lane & 31, hi = lane >> 5;
    const int side = MODE == 0 ? (wid & 1) : (wid >> 2), qblk = MODE == 0 ? (wid >> 1) : (wid & 3);
    LAS unsigned char* lds = F.lds;
    const int qrow0 = (isctx ? ML + b * CT : b * T) + 128 * qt + 32 * qblk;
    const int kq = isctx ? 0 : 1 + (qt >> 1);
    const int jlo = MODE == 0 ? (isctx ? 32 : 0) : 4 * kq, jhi = MODE == 0 ? 36 : 4 * kq + 4;
    const int jd = MODE == 1 ? ((isctx ? 0 : 4) + 2 * qt + (qblk >> 1)) : 0;
    const bf16* Ksrc = MODE == 0 ? A.QKV + 512 + h * 128 : A.MQK + 512 + h * 128; const int Kld = MODE == 0 ? NQ : D;
    const bf16* Vsrc = A.QKV + (MODE == 0 ? 1024 : 2560) + h * 128;
    const int key0 = tid >> 4, c16 = tid & 15;
    const unsigned kdst0 = c16 * 1024 + ((key0 ^ c16) << 4), kdst1 = c16 * 1024 + (((key0 + 32) ^ c16) << 4);
    const unsigned vdst0 = 16384 + (c16 >> 2) * 4096 + (key0 ^ (c16 >> 2)) * 64 + (c16 & 3) * 16, vdst1 = vdst0 + 32 * 64;
    const float* colsrc = A.scan + SC_COL + (size_t)((wid & 1) * 32 + b * 4 + h) * TT;
    const unsigned koff0 = (unsigned)(key0 * Kld + 8 * c16) * 2u, koff1 = koff0 + 64u * (unsigned)Kld, voff0 = (unsigned)(key0 * NQ + 8 * c16) * 2u, voff1 = voff0 + 64u * (unsigned)NQ;
#define TILE_ROW0(j) (MODE == 0 ? ((j) < 32 ? b * T + 64 * (j) : ML + b * CT + 64 * ((j) - 32)) : ((j) < 4 ? ML + b * CT + 64 * (j) : b * T + 64 * ((j) - 4)))
    bf16x8 qf[KS];
    const bf16* qbase = MODE == 0 ? A.QKV + (size_t)qrow0 * NQ + h * 128 + side * 64 : A.MQK + (size_t)qrow0 * D + h * 128;
    unsigned qoff = (unsigned)(r32 * (MODE == 0 ? NQ : D) + 8 * hi) * 2u;
#define LOAD_Q() do { _Pragma("unroll") for (int d0 = 0; d0 < KS; ++d0) qf[d0] = *(const bf16x8*)((const char*)qbase + qoff + 32 * d0); } while (0)
    if (MODE == 0) LOAD_Q();
    float rowv = 0.f;
    if (MODE == 1) rowv = A.scan[SC_ROW + (size_t)(side * 32 + b * 4 + h) * TT + (isctx ? 0 : CT) + 128 * qt + 32 * qblk + r32];
    f32x16 o[4];
#pragma unroll
    for (int d0 = 0; d0 < 4; ++d0)
#pragma unroll
        for (int i = 0; i < 16; ++i) o[d0][i] = 0.f;
    float lsum = 0.f;
    u32x4 kr0, kr1, vr0, vr1; float cr = 0.f;
#define LOAD_TILE(j) do { const int tr0_ = TILE_ROW0(j); const char* kt_ = (const char*)(Ksrc + (size_t)tr0_ * Kld); const char* vt_ = (const char*)(Vsrc + (size_t)tr0_ * NQ); \
        kr0 = *(const u32x4*)(kt_ + koff0); kr1 = *(const u32x4*)(kt_ + koff1); vr0 = *(const u32x4*)(vt_ + voff0); vr1 = *(const u32x4*)(vt_ + voff1); \
        if (MODE == 1 && wid < 2) cr = colsrc[(unsigned)(64 * (j) + lane)]; } while (0)
#define STORE_TILE(slot) do { LAS unsigned char* d_ = lds + (slot) * 32768; \
        *(LAS u32x4*)(d_ + kdst0) = kr0; *(LAS u32x4*)(d_ + kdst1) = kr1; *(LAS u32x4*)(d_ + vdst0) = vr0; *(LAS u32x4*)(d_ + vdst1) = vr1; \
        if (MODE == 1 && wid < 2) ((LAS float*)(lds + 65536 + (slot) * 512))[tid] = cr; } while (0)
    const unsigned vb = ((lane >> 4) & 1) * 32 + (lane & 3) * 8 + (4 * hi + ((lane & 15) >> 2)) * 64;
#define QK_S(P0, P1, Kb_) do { \
        _Pragma("unroll") for (int i = 0; i < 16; ++i) { P0[i] = MODE == 0 ? A.negm : 0.f; P1[i] = MODE == 0 ? A.negm : 0.f; } \
        _Pragma("unroll") for (int d0 = 0; d0 < KS; ++d0) { const int ck = (MODE == 0 ? side * 8 : 0) + 2 * d0 + hi; \
            const bf16x8 k0 = *(const LAS bf16x8*)((Kb_) + ck * 1024 + ((r32 ^ ck) << 4)); const bf16x8 k1 = *(const LAS bf16x8*)((Kb_) + ck * 1024 + (((r32 + 32) ^ ck) << 4)); \
            P0 = __builtin_amdgcn_mfma_f32_32x32x16_bf16(k0, qf[d0], P0, 0, 0, 0); P1 = __builtin_amdgcn_mfma_f32_32x32x16_bf16(k1, qf[d0], P1, 0, 0, 0); } } while (0)
#define PV_O(P0, P1, Vb_) do { \
        const bf16x8 pa0 = pack8(P0, 0), pa1 = pack8(P0, 1), pa2 = pack8(P1, 0), pa3 = pack8(P1, 1); \
        _Pragma("unroll") for (int d0 = 0; d0 < 4; ++d0) { const LAS unsigned char* vp = (Vb_) + d0 * 4096 + (vb ^ (d0 << 6)); s16x4 lo[4], hh[4]; \
            _Pragma("unroll") for (int ks = 0; ks < 4; ++ks) { lo[ks] = vtr(vp + ks * 1024); hh[ks] = vtr(vp + ks * 1024 + 512); } \
            o[d0] = __builtin_amdgcn_mfma_f32_32x32x16_bf16(pa0, VFRG(0), o[d0], 0, 0, 0); o[d0] = __builtin_amdgcn_mfma_f32_32x32x16_bf16(pa1, VFRG(1), o[d0], 0, 0, 0); \
            o[d0] = __builtin_amdgcn_mfma_f32_32x32x16_bf16(pa2, VFRG(2), o[d0], 0, 0, 0); o[d0] = __builtin_amdgcn_mfma_f32_32x32x16_bf16(pa3, VFRG(3), o[d0], 0, 0, 0); } } while (0)
#define VFRG(k) (bf16x8){lo[k][0], lo[k][1], lo[k][2], lo[k][3], hh[k][0], hh[k][1], hh[k][2], hh[k][3]}
    if constexpr (MODE == 0) {
        const int nt = jhi - jlo, rot = isctx ? 0 : (qt * nt) >> 4;
#define TJ(x) (jlo + (((x) - jlo + rot) >= nt ? ((x) - jlo + rot) - nt : ((x) - jlo + rot)))
        LOAD_TILE(TJ(jlo)); STORE_TILE(0); LOAD_TILE(TJ(jlo + 1)); STORE_TILE(1);
        __syncthreads();
        f32x16 s0, s1; QK_S(s0, s1, lds);
        int cur = 0;
        for (int j = jlo; j < jhi; ++j) {
            const int nx = cur == 2 ? 0 : cur + 1, nn = nx == 2 ? 0 : nx + 1;
            const bool more1 = j + 1 < jhi, more2 = j + 2 < jhi;
            if (more2) LOAD_TILE(TJ(j + 2));
            f32x16 n0 = s0, n1 = s1;
            if (more1) QK_S(n0, n1, lds + nx * 32768);
            float ts = 0.f;
#pragma unroll
            for (int i = 0; i < 16; ++i) { s0[i] = __builtin_amdgcn_exp2f(s0[i]); s1[i] = __builtin_amdgcn_exp2f(s1[i]); ts += s0[i] + s1[i]; }
            lsum += ts;
            PV_O(s0, s1, lds + cur * 32768 + 16384);
            if (more2) STORE_TILE(nn);
            s0 = n0; s1 = n1; cur = nx;
            __syncthreads();
        }
    } else {
    LOAD_TILE(jlo); STORE_TILE(0);
    __syncthreads();
    for (int j = jlo; j < jhi; ++j) {
        const int cur = (j - jlo) & 1;
        const bool more = j + 1 < jhi;
        if (more) LOAD_TILE(j + 1);
        const bool masked = (j == jd), active = side == 0 ? (j <= jd) : (j >= jd);
        if (active) {
            const LAS unsigned char* Kb = lds + cur * 32768;
            f32x16 p0, p1;
            asm volatile("" : "+v"(qoff)); LOAD_Q();
            QK_S(p0, p1, Kb);
            {
                const LAS float* colp = (const LAS float*)(lds + 65536 + cur * 512 + side * 256) + 4 * hi;
                const int qidx = 32 * (qblk & 1) + r32;
#pragma unroll
                for (int g = 0; g < 4; ++g) {
                    const f32x4 c0 = *(const LAS f32x4*)(colp + 8 * g), c1 = *(const LAS f32x4*)(colp + 32 + 8 * g);
#pragma unroll
                    for (int k = 0; k < 4; ++k) {
                        float e0 = rowv - c0[k], e1 = rowv - c1[k];
                        if (masked) { const int kv0 = 8 * g + 4 * hi + k, kv1 = kv0 + 32;
                            const bool keep0 = side == 0 ? (kv0 <= qidx) : (kv0 >= qidx), keep1 = side == 0 ? (kv1 <= qidx) : (kv1 >= qidx);
                            e0 = keep0 ? e0 : -1.0e30f; e1 = keep1 ? e1 : -1.0e30f; }
                        p0[4 * g + k] *= __builtin_amdgcn_exp2f(e0); p1[4 * g + k] *= __builtin_amdgcn_exp2f(e1);
                    }
                }
            }
            float ts = 0.f;
#pragma unroll
            for (int i = 0; i < 16; ++i) ts += p0[i] + p1[i];
            lsum += ts;
            PV_O(p0, p1, Kb + 16384);
        }
        if (more) STORE_TILE(cur ^ 1);
        __syncthreads();
    }
    }
#undef TJ
#undef VFRG
#undef QK_S
#undef PV_O
    if (MODE == 1 && !isctx) {
        const int slot0 = kq - 1, slot1 = kq == 8 ? 0 : kq + 1;
        {
            int tid2 = tid; asm volatile("" : "+v"(tid2));
            const int c16s = tid2 & 15, rr = tid2 >> 4;
#pragma unroll
            for (int d = 0; d < 2; ++d) { const float* src = A.DC + ((size_t)(((d * 32 + b * 4 + h) * 9) + (d ? slot1 : slot0)) << 14);
#pragma unroll
                for (int g = 0; g < 4; ++g) { const int dk = rr + 32 * g; const f32x4 x0 = *(const f32x4*)(src + dk * 128 + 8 * c16s), x1 = *(const f32x4*)(src + dk * 128 + 8 * c16s + 4);
                    u32x4 w; w.x = pk2(x0[0], x0[1]); w.y = pk2(x0[2], x0[3]); w.z = pk2(x1[0], x1[1]); w.w = pk2(x1[2], x1[3]);
                    *(LAS u32x4*)(lds + d * 32768 + (c16s >> 2) * 8192 + dk * 64 + (c16s & 3) * 16) = w; } }
        }
        const int uref = side == 0 ? 256 * kq - 1 : 256 * slot1;
        const float rt = __builtin_amdgcn_exp2f(rowv - A.scan[SC_ROW + (size_t)(side * 32 + b * 4 + h) * TT + uref]);
        int lane2 = lane; asm volatile("" : "+v"(lane2));
        const float* nst = A.scan + SC_DN + ((side * 32 + b * 4 + h) * 9 + (side ? slot1 : slot0)) * 128 + 8 * (lane2 >> 5);
        float qn = 0.f; asm volatile("" : "+v"(qoff)); LOAD_Q();
#pragma unroll
        for (int d0 = 0; d0 < KS; ++d0) {
            const f32x4 n0 = *(const f32x4*)(nst + 16 * d0), n1 = *(const f32x4*)(nst + 16 * d0 + 4);
            const u32x4 qw = __builtin_bit_cast(u32x4, qf[d0]); u32x4 ow;
#pragma unroll
            for (int i = 0; i < 4; ++i) { const float lo_ = bf2f(qw[i] & 0xffffu), hi_ = bf2f(qw[i] >> 16);
                qn += lo_ * (i < 2 ? n0[2 * i] : n1[2 * i - 4]) + hi_ * (i < 2 ? n0[2 * i + 1] : n1[2 * i - 3]);
                ow[i] = pk2(lo_ * rt, hi_ * rt); }
            qf[d0] = __builtin_bit_cast(bf16x8, ow);
        }
        lsum += rt * qn;
        __syncthreads();
        const unsigned vbn = ((lane2 >> 4) & 1) * 32 + (lane2 & 3) * 8 + (8 * (lane2 >> 5) + ((lane2 & 15) >> 2)) * 64;
        const LAS unsigned char* Cb = lds + side * 32768 + vbn;
#pragma unroll
        for (int d0 = 0; d0 < 4; ++d0)
#pragma unroll
            for (int ks = 0; ks < KS; ++ks) { const s16x4 bl = vtr(Cb + d0 * 8192 + ks * 1024), bh = vtr(Cb + d0 * 8192 + ks * 1024 + 256);
                o[d0] = __builtin_amdgcn_mfma_f32_32x32x16_bf16(qf[ks], (bf16x8){bl[0], bl[1], bl[2], bl[3], bh[0], bh[1], bh[2], bh[3]}, o[d0], 0, 0, 0); }
        __syncthreads();
    }
    {
        float tot = lsum + __shfl_xor(lsum, 32), inv;
        if (MODE == 0) inv = 1.0f / tot;
        else { const float fl = expf(-A.scan[SC_LMX + side * 32 + b * 4 + h]); inv = 1.0f / fmaxf(fabsf(tot), fl); }
        LAS float* wsf = (LAS float*)(lds + SMALL_OFF + 1024 + wid * 128);
        if (hi == 0) wsf[r32] = inv;
        LDS_WAIT();
#pragma unroll
        for (int i = 0; i < 16; ++i) { const float li = wsf[crow(i, hi)];
#pragma unroll
            for (int d0 = 0; d0 < 4; ++d0) o[d0][i] *= li; }
    }
    LAS float* xch = (LAS float*)(lds + qblk * 16384);
    if (side == 1) {
#pragma unroll
        for (int d0 = 0; d0 < 4; ++d0)
#pragma unroll
            for (int i = 0; i < 16; ++i) xch[(d0 * 16 + i) * 64 + lane] = o[d0][i];
    }
    __syncthreads();
    if (side == 0) {
#pragma unroll
        for (int d0 = 0; d0 < 4; ++d0)
#pragma unroll
            for (int i = 0; i < 16; ++i) { const float x2 = xch[(d0 * 16 + i) * 64 + lane]; o[d0][i] = MODE == 0 ? o[d0][i] - A.lam * x2 : o[d0][i] + x2; }
    }
    __syncthreads();
    if (side == 0) {
        LAS float* rb = (LAS float*)lds + (qblk * 32 + 4 * hi) * 132 + r32;
#pragma unroll
        for (int d0 = 0; d0 < 4; ++d0)
#pragma unroll
            for (int i = 0; i < 16; ++i) rb[((i & 3) + 8 * (i >> 2)) * 132 + 32 * d0] = o[d0][i];
    }
    __syncthreads();
    {
        int tid3 = tid; asm volatile("" : "+v"(tid3));
        const int urow0 = (isctx ? ML + b * CT : b * T) + 128 * qt;
#pragma unroll
        for (int it = 0; it < 4; ++it) {
            const int idx = tid3 + 512 * it, row = idx >> 4, seg = idx & 15;
            const LAS float* rp = (const LAS float*)lds + row * 132 + 8 * seg;
            const f32x4 a0 = *(const LAS f32x4*)rp, a1 = *(const LAS f32x4*)(rp + 4);
            float ss = (a0[0] * a0[0] + a0[1] * a0[1]) + (a0[2] * a0[2] + a0[3] * a0[3]) + (a1[0] * a1[0] + a1[1] * a1[1]) + (a1[2] * a1[2] + a1[3] * a1[3]);
            ss += __shfl_xor(ss, 1); ss += __shfl_xor(ss, 2); ss += __shfl_xor(ss, 4); ss += __shfl_xor(ss, 8);
            const float rstd = 1.0f / sqrtf(ss * (1.0f / 128.0f) + EPS);
            const float* gp = A.gain + (MODE == 0 ? 0 : h * 128) + 8 * seg;
            f32x4 g0 = *(const f32x4*)gp, g1 = *(const f32x4*)(gp + 4);
            const size_t grow = (size_t)(urow0 + row);
            if (MODE == 0) { g0 = g0 * (rstd * A.post); g1 = g1 * (rstd * A.post); }
            else { const u32x4 og = *(const u32x4*)(A.QKV + grow * NQ + 3072 + h * 128 + 8 * seg);
#pragma unroll
                for (int k = 0; k < 4; ++k) { const float s0 = 1.0f / (1.0f + expf(-bf2f(og[k] & 0xffffu))), s1 = 1.0f / (1.0f + expf(-bf2f(og[k] >> 16)));
                    if (k < 2) { g0[2 * k] *= rstd * s0; g0[2 * k + 1] *= rstd * s1; } else { g1[2 * k - 4] *= rstd * s0; g1[2 * k - 3] *= rstd * s1; } } }
            const f32x4 v0 = a0 * g0, v1 = a1 * g1;
            u32x4 w; w.x = pk2(v0[0], v0[1]); w.y = pk2(v0[2], v0[3]); w.z = pk2(v1[0], v1[1]); w.w = pk2(v1[2], v1[3]);
            *(u32x4*)(A.CAT + grow * D + (MODE == 0 ? 0 : 512) + h * 128 + 8 * seg) = w;
        }
    }
    __syncthreads();
#undef LOAD_TILE
#undef LOAD_Q
#undef STORE_TILE
#undef TILE_ROW0
}
DI void mixer_phase(const Frame& F, int l, bool need_ctx, int part) {
    const KArgs ka = kargs(); unsigned char* ws = ka->ws;
    LAS float* sm = (LAS float*)(F.lds + SMALL_OFF);
    if (F.wave == 0) {
        const int ln = F.lane;
        const float s1 = wave_sum(ka->in[I_LQ1][l * 64 + ln] * ka->in[I_LK1][l * 64 + ln]), s2 = wave_sum(ka->in[I_LQ2][l * 64 + ln] * ka->in[I_LK2][l * 64 + ln]);
        const float mq = wave_max(fabsf(ka->in[I_QNG][l * 64 + ln])), mk = wave_max(fabsf(ka->in[I_KNG][l * 64 + ln]));
        const float lam_init = 0.8f - 0.6f * expf(-0.3f * (float)l);
        if (ln == 0) { sm[0] = expf(s1) - expf(s2) + lam_init; sm[1] = 1.0f - lam_init; sm[2] = -(8.0f * mq * mk * LOG2E); }
    }
    __syncthreads();
    MixArgs A; A.QKV = (const bf16*)(ws + WS_QKV); A.MQK = (const bf16*)(ws + WS_H); A.CAT = (bf16*)(ws + WS_CAT); A.scan = (const float*)(ws + WS_SCAN); A.DC = (const float*)(ws + WS_DC);
    A.lam = sm[0]; A.post = sm[1]; A.negm = sm[2];
    const int nunits = need_ctx ? 576 : 512;
    if (part == 1) {
        A.gain = ka->in[I_MNG] + l * 512;
        for (int u = F.vcu; u < nunits; u += F.G) {
            const bool isctx = u >= 512; const int v = u - 512;
            mix_unit<1>(F, A, isctx ? v >> 3 : u >> 6, isctx ? (v >> 1) & 3 : (u >> 4) & 3, isctx ? v & 1 : u & 15, isctx);
        }
    }
    A.gain = ka->in[I_SUBLN] + l * 128;
    for (int u = (part == 0 ? F.vcu : 256 + (F.vcu + F.G - 64) % F.G); u < (part == 0 ? 256 : nunits); u += F.G) {
        const bool isctx = u >= 512; const int v = u - 512;
        mix_unit<0>(F, A, isctx ? v >> 3 : u >> 6, isctx ? (v >> 1) & 3 : (u >> 4) & 3, isctx ? v & 1 : u & 15, isctx);
    }
}

constexpr int MOE_TAIL_PM = 64;
DI void moe_tstart(const Frame& F, const unsigned char* ws, int half) {
    LAS int* ts = (LAS int*)(F.lds + SMALL_OFF + 64);
    if (F.tid == 0) { const unsigned* cnt = (const unsigned*)(ws + WS_CTL) + CW_CNT + half * 8; int acc = 0;
        for (int e = 0; e < 8; ++e) { ts[e] = acc; acc += ((int)__hip_atomic_load(cnt + e, RLX_AGENT) + 255) >> 8; } ts[8] = acc; }
    __syncthreads();
}
DI void moe_gather(const Frame& F, unsigned char* ws, int half) {
    moe_tstart(F, ws, half);
    const LAS int* ts = (const LAS int*)(F.lds + SMALL_OFF + 64);
    const bf16* H = (const bf16*)(ws + WS_H); bf16* HG = (bf16*)(ws + WS_CAT);
    int* rowmap = (int*)(ws + WS_SMALL + SM_ROWMAP) + half * MR; float* roww = (float*)(ws + WS_SMALL + SM_ROWW) + half * MR;
    const int gw = F.vcu * NWAVES + F.wave, NGW = F.G * NWAVES;
#pragma unroll 4
    for (int tk = gw; tk < ML / 2; tk += NGW) {
        const int token = half * (ML / 2) + tk;
        const u32x4* rec = (const u32x4*)(ws + WS_SMALL + SM_ROUTE + (size_t)token * 32);
        const u32x4 r0 = rec[0], r1 = rec[1];
        const u32x4* src = (const u32x4*)(H + (size_t)token * D) + F.lane;
        const u32x4 v0 = src[0], v1 = src[64];
#pragma unroll
        for (int s = 0; s < 2; ++s) {
            const int e = (int)(s ? r0.y : r0.x), pos = (int)(s ? r0.w : r0.z); const int dst = 256 * ts[e] + pos;
            u32x4* d = (u32x4*)(HG + (size_t)dst * D) + F.lane; d[0] = v0; d[64] = v1;
            if (F.lane == 0) { rowmap[dst] = token * 2 + s; roww[dst] = __uint_as_float(s ? r1.y : r1.x); }
        }
    }
    const unsigned* cnt = (const unsigned*)(ws + WS_CTL) + CW_CNT + half * 8;
    for (int pr = gw; pr < 8 * 256; pr += NGW) {
        const int e = pr >> 8, k = pr & 255; const int c = (int)__hip_atomic_load(cnt + e, RLX_AGENT); const int npad = (((c + 255) >> 8) << 8) - c;
        if (k < npad) { const int dst = 256 * ts[e] + c + k; u32x4* d = (u32x4*)(HG + (size_t)dst * D) + F.lane; d[0] = (u32x4){0u, 0u, 0u, 0u}; d[64] = (u32x4){0u, 0u, 0u, 0u};
            if (F.lane == 0) { rowmap[dst] = -1; roww[dst] = 0.f; } }
    }
}
DI void moe_combine(const Frame& F, const unsigned char* ws, float* out, const float* g2) {
    const bf16* Y = (const bf16*)(ws + WS_XA); const bf16* YT = (const bf16*)(ws + WS_DC);
    LAS int* ts2 = (LAS int*)(F.lds + SMALL_OFF + 128);
    if (F.tid < 2) { const unsigned* cnt = (const unsigned*)(ws + WS_CTL) + CW_CNT + F.tid * 8; int acc = 0;
        for (int e = 0; e < 8; ++e) { ts2[F.tid * 9 + e] = acc; acc += ((int)__hip_atomic_load(cnt + e, RLX_AGENT) + 255) >> 8; } ts2[F.tid * 9 + 8] = acc; }
    __syncthreads();
    const int gw = F.vcu * NWAVES + F.wave, NGW = F.G * NWAVES;
#pragma unroll 2
    for (int token = gw; token < ML; token += NGW) {
        const float* gp = g2 + (token >> 11) * ADA_LD; const int half = token >> 13;
        const u32x4 r0 = *(const u32x4*)(ws + WS_SMALL + SM_ROUTE + (size_t)token * 32);
        const int dst0 = 256 * ts2[half * 9 + (int)r0.x] + (int)r0.z - MOE_TAIL_PM * 256, dst1 = 256 * ts2[half * 9 + (int)r0.y] + (int)r0.w - MOE_TAIL_PM * 256;
#pragma unroll
        for (int j = 0; j < 2; ++j) {
            const int c = 8 * F.lane + 512 * j;
            float ys[8];
#pragma unroll
            for (int i = 0; i < 8; ++i) ys[i] = 0.f;
#pragma unroll
            for (int s = 0; s < 2; ++s) { const int dst = s ? dst1 : dst0;
                if (dst < 0) { const u32x4 y = *(const u32x4*)(Y + (size_t)(2 * token + s) * D + c);
#pragma unroll
                    for (int i = 0; i < 4; ++i) { ys[2 * i] += bf2f(y[i] & 0xffffu); ys[2 * i + 1] += bf2f(y[i] >> 16); } }
                else {
#pragma unroll
                    for (int q = 0; q < 4; ++q) { const u32x4 y = *(const u32x4*)(YT + (((size_t)half * 4 + q) * 2048 + dst) * D + c);
#pragma unroll
                        for (int i = 0; i < 4; ++i) { ys[2 * i] += bf2f(y[i] & 0xffffu); ys[2 * i + 1] += bf2f(y[i] >> 16); } } }
            }
            float* op = out + (size_t)token * D + c;
            f32x4 o0 = *(const f32x4*)op, o1 = *(const f32x4*)(op + 4); const f32x4 g0 = *(const f32x4*)(gp + c), g1 = *(const f32x4*)(gp + c + 4);
#pragma unroll
            for (int i = 0; i < 4; ++i) { o0[i] += g0[i] * ys[i]; o1[i] += g1[i] * ys[4 + i]; }
            *(f32x4*)op = o0; *(f32x4*)(op + 4) = o1;
        }
    }
}
DI void moe_up(const Frame& F, unsigned char* ws, int half) {
    moe_tstart(F, ws, half);
    pg8::Gemm g{(const bf16*)(ws + WS_CAT), (const bf16*)(ws + WS_MUP), MR, 2 * FFE, D, D}; pg8::MoeOrder S{(const LAS int*)(F.lds + SMALL_OFF + 64), 2 * FFE / 256, F.G, F.vcu, 1 << 20};
    pg8::EpiGated E{(bf16*)(ws + WS_QKV), FFE, 2 * FFE / 256};
    pg8::gemm_phase<pg8::EpiGated, pg8::MoeOrder, PG8_ALIGN, PG8_SP2>(F.lds, g, S, E);
}
DI void moe_down(const Frame& F, unsigned char* ws, int half) {
    moe_tstart(F, ws, half);
    const int* rowmap = (const int*)(ws + WS_SMALL + SM_ROWMAP) + half * MR; const float* roww = (const float*)(ws + WS_SMALL + SM_ROWW) + half * MR;
    {
        pg8::Gemm g{(const bf16*)(ws + WS_QKV), (const bf16*)(ws + WS_MDN), MR, D, FFE, FFE}; pg8::MoeOrder S{(const LAS int*)(F.lds + SMALL_OFF + 64), D / 256, F.G, F.vcu, MOE_TAIL_PM};
        pg8::EpiScatter E{(bf16*)(ws + WS_XA), rowmap, roww};
        pg8::gemm_phase<pg8::EpiScatter, pg8::MoeOrder, PG8_ALIGN, PG8_SP2>(F.lds, g, S, E);
    }
    __syncthreads();
    {
        pg8::Gemm g{(const bf16*)(ws + WS_QKV), (const bf16*)(ws + WS_MDN), MR, D, FFE / 4, FFE}; pg8::MoeTailOrder S{(const LAS int*)(F.lds + SMALL_OFF + 64), F.vcu, MOE_TAIL_PM, FFE / 4 * 2};
        pg8::EpiScatterTail E{(bf16*)(ws + WS_DC) + (size_t)half * 4 * 2048 * D, roww, FFE / 4 * 2};
        pg8::gemm_phase<pg8::EpiScatterTail, pg8::MoeTailOrder, false, PG8_SP2>(F.lds, g, S, E);
    }
}
#ifndef PHMASK
#define PHMASK 0x7FFFFF
#endif
#define IN(k) (((PHMASK >> (k)) & 1) && lo <= (k) && (k) < hi)
#define SEAM(k) do { if (!MK_PER_PHASE && IN((k) + 1)) xcd_barrier(bar); } while (0)
template <int L>
DI void layer_phases(const Frame& F0, const XcdBarrier& bar, const int lo, const int hi) {
    constexpr int l = L;
    unsigned char* ws = kargs()->ws;
    const float* ada = (const float*)(ws + WS_ADA);
    bf16* const QKV = (bf16*)(ws + WS_QKV); bf16* const CAT = (bf16*)(ws + WS_CAT); bf16* const H = (bf16*)(ws + WS_H); float* const XA = (float*)(ws + WS_XA);
    float* const gates = (float*)(ws + WS_GATES); float* const scan = (float*)(ws + WS_SCAN);
        const int pb = 1 + 9 * l;
        const float* adal = ada + l * ADA_L;
        const float* xinL = l == 0 ? kargs()->in[I_X] : XA; const float* xinC = l == 0 ? kargs()->in[I_CTX] : XA + (size_t)ML * D;
        if (IN(pb + 0)) { const Frame F = fresh(F0); modulate_phase<0>(F, xinL, xinC, MR, kargs()->in[I_N1G] + l * D, adal, 0, 1024, H, kargs()->in[I_WIN] + (size_t)l * D * INC, gates, ws); SEAM(pb + 0); }
        if (IN(pb + 1)) { const Frame F = fresh(F0);
            scan_phase(F, gates, kargs()->in[I_GATEB] + l * 16, scan);
            pg8::Gemm g{H, (const bf16*)(ws + WS_WIN) + (size_t)l * NQ * D, MR, NQ, D, D}; pg8::StaticOrder S; S.init(MR, NQ, F.G, (int)blockIdx.x);
            const float* rope = (const float*)(ws + WS_SMALL + SM_ROPE);
            pg8::EpiQKV E{QKV, kargs()->in[I_QNG] + l * 64, kargs()->in[I_KNG] + l * 64, rope, rope + 1024};
            pg8::gemm_phase<pg8::EpiQKV, pg8::StaticOrder, PG8_ALIGN, PG8_SP2>(F.lds, g, S, E);
            SEAM(pb + 1);
        }
        if (IN(pb + 2)) { const Frame F = fresh(F0);
            conv_phase(F, QKV, H, kargs()->in[I_CONVW] + l * 5 * 1024, kargs()->in[I_CONVB] + l * 1024);
            for (int u = (F.vcu + F.G - 64) % F.G; u < 288; u += F.G)
                mstate_unit(F, QKV, scan, kargs()->in[I_CONVW] + l * 5 * 1024, kargs()->in[I_CONVB] + l * 1024, (float*)(ws + WS_DC), u / 36, (u / 9) & 3, u % 9);
            SEAM(pb + 2);
        }
        if (IN(pb + 3)) { const Frame F = fresh(F0); mprefix_phase(F, scan, (float*)(ws + WS_DC)); __syncthreads(); mixer_phase(F, l, l == 0, 0); SEAM(pb + 3); }
        if (IN(pb + 4)) { const Frame F = fresh(F0); mixer_phase(F, l, l == 0, 1); SEAM(pb + 4); }
        if (IN(pb + 5)) { const Frame F = fresh(F0);
            const int M4 = l == 0 ? MR : ML;
            pg8::Gemm g{CAT, (const bf16*)(ws + WS_WOUT) + (size_t)l * D * D, M4, D, D, D}; pg8::StaticOrder S; S.init(M4, D, F.G, (int)blockIdx.x);
            pg8::EpiRes E{xinL, xinC, l == 0 ? XA : kargs()->out, adal + 2048};
            pg8::gemm_phase<pg8::EpiRes, pg8::StaticOrder, PG8_ALIGN, PG8_SP2>(F.lds, g, S, E);
            if (l == 0) idle_convert(F, (MR / 256) * (D / 256), CV_PRO, CV_P4);
            SEAM(pb + 5);
        }
        if (l == 0) {
            if (IN(pb + 6)) { const Frame F = fresh(F0); modulate_phase<1>(F, XA, XA + (size_t)ML * D, MR, kargs()->in[I_N2G], adal, 3072, 4096, H, nullptr, nullptr, ws); SEAM(pb + 6); }
            if (IN(pb + 7)) { const Frame F = fresh(F0);
                pg8::Gemm g{H, (const bf16*)(ws + WS_WUP), MR, 2 * FF, D, D}; pg8::StaticOrder S; S.init(MR, 2 * FF, F.G, (int)blockIdx.x);
                pg8::EpiGated E{QKV, FF, 1 << 20};
                pg8::gemm_phase<pg8::EpiGated, pg8::StaticOrder, PG8_ALIGN, PG8_SP2>(F.lds, g, S, E);
                idle_convert(F, (MR / 256) * (2 * FF / 256), CV_P4, CV_P6);
                SEAM(pb + 7);
            }
            if (IN(pb + 8)) { const Frame F = fresh(F0);
                pg8::Gemm g{QKV, (const bf16*)(ws + WS_WDN), MR, D, FF, FF}; pg8::StaticOrder S; S.init(MR, D, F.G, (int)blockIdx.x);
                pg8::EpiRes E{XA, XA + (size_t)ML * D, XA, adal + 5120};
                pg8::gemm_phase<pg8::EpiRes, pg8::StaticOrder, PG8_ALIGN, PG8_SP2>(F.lds, g, S, E);
                idle_convert(F, (MR / 256) * (D / 256), CV_P6, CV_ALL);
                SEAM(pb + 8);
            }
        } else {
            if (IN(16)) { const Frame F = fresh(F0); modulate_phase<2>(F, kargs()->out, kargs()->out, ML, kargs()->in[I_N2G] + D, adal, 3072, 4096, H, kargs()->in[I_RW], nullptr, ws); SEAM(16); }
            if (IN(17)) { const Frame F = fresh(F0); moe_gather(F, ws, 0); SEAM(17); }
            if (IN(18)) { const Frame F = fresh(F0); moe_up(F, ws, 0); SEAM(18); }
            if (IN(19)) { const Frame F = fresh(F0); moe_down(F, ws, 0); __syncthreads(); moe_gather(F, ws, 1); SEAM(19); }
            if (IN(20)) { const Frame F = fresh(F0); moe_up(F, ws, 1); SEAM(20); }
            if (IN(21)) { const Frame F = fresh(F0); moe_down(F, ws, 1); SEAM(21); }
            if (IN(22)) { const Frame F = fresh(F0); moe_combine(F, ws, kargs()->out, adal + 5120); }
        }
    }
#undef IN
#undef SEAM

constexpr int NPHASES = 23;
__global__ void __launch_bounds__(NWAVES * 64, 2) fwd_kernel(Args args) {
    extern __shared__ __attribute__((aligned(16))) unsigned char lds_raw[];
    Frame F;
    F.lds = (LAS unsigned char*)lds_raw;
    F.tid = threadIdx.x; F.lane = F.tid & 63; F.wave = __builtin_amdgcn_readfirstlane(F.tid >> 6);
    F.G = gridDim.x; { const int bx = blockIdx.x; F.vcu = (F.G % 8 == 0) ? (bx % 8) * (F.G / 8) + bx / 8 : bx; }
    unsigned char* ws = kargs()->ws;
    for (int u = F.tid; u < (LDS_BYTES - LDSCTL_OFF) / 4; u += NWAVES * 64) ((LAS unsigned*)(F.lds + LDSCTL_OFF))[u] = 0u;
    __syncthreads();
    XcdBarrier bar; bar.bar = (unsigned*)(ws + WS_CTL) + CW_BAR; bar.x = 0; bar.st = nullptr;
    if (!MK_PER_PHASE) bar = xcd_barrier_post((unsigned*)(ws + WS_CTL) + CW_BAR, (volatile LAS unsigned*)(F.lds + MISC_OFF) + 8);
    const int lo = kargs()->ph_lo, hi = kargs()->ph_hi;
#ifndef PHMASK
#define PHMASK 0x7FFFFF
#endif
#define IN(k) (((PHMASK >> (k)) & 1) && lo <= (k) && (k) < hi)
#define SEAM(k) do { if (!MK_PER_PHASE && IN((k) + 1)) xcd_barrier(bar); } while (0)
    const float* ada = (const float*)(ws + WS_ADA);
    bf16* const QKV = (bf16*)(ws + WS_QKV); bf16* const CAT = (bf16*)(ws + WS_CAT); bf16* const H = (bf16*)(ws + WS_H); float* const XA = (float*)(ws + WS_XA);
    float* const gates = (float*)(ws + WS_GATES); float* const scan = (float*)(ws + WS_SCAN);

    if (IN(0)) { const Frame Fp = fresh(F); p0_prologue(Fp); SEAM(0); }

    layer_phases<0>(F, bar, lo, hi);
    layer_phases<1>(F, bar, lo, hi);
#undef IN
#undef SEAM
}

extern "C" void kernel_launch(void* const* d_in, const int* in_sizes, int n_in, void* d_out, int out_size, void* d_ws, size_t ws_size, hipStream_t stream) {
    static int grid = 0;
    if (grid == 0) {
        if (n_in != 28 || in_sizes[0] != ML * D || out_size != ML * D || ws_size < WS_END) { fprintf(stderr, "kernel_launch: unexpected shapes / workspace (n_in %d, out %d, ws %zu < %zu)\n", n_in, out_size, ws_size, (size_t)WS_END); grid = -1; return; }
        int dev = 0, cus = 0, per_cu = 0;
        if (hipGetDevice(&dev) != hipSuccess || hipDeviceGetAttribute(&cus, hipDeviceAttributeMultiprocessorCount, dev) != hipSuccess) { grid = -1; return; }
        if (hipFuncSetAttribute((const void*)fwd_kernel, hipFuncAttributeMaxDynamicSharedMemorySize, LDS_BYTES) != hipSuccess) { fprintf(stderr, "kernel_launch: hipFuncSetAttribute failed\n"); grid = -1; return; }
        if (hipOccupancyMaxActiveBlocksPerMultiprocessor(&per_cu, (const void*)fwd_kernel, NWAVES * 64, LDS_BYTES) != hipSuccess || per_cu < 1) { fprintf(stderr, "kernel_launch: occupancy query says %d\n", per_cu); }
        (void)hipGetLastError();
        grid = cus;
    }
    if (grid < 0) return;
    if (hipMemsetAsync((char*)d_ws + WS_CTL, 0, CTL_ZERO_BYTES, stream) != hipSuccess) return;
    Args a{};
    for (int i = 0; i < 28; ++i) a.in[i] = (const float*)d_in[i];
    a.out = (float*)d_out; a.ws = (unsigned char*)d_ws;
#if MK_PER_PHASE
    for (int p = 0; p < NPHASES; ++p) { a.ph_lo = p; a.ph_hi = p + 1; hipLaunchKernelGGL(fwd_kernel, dim3(grid), dim3(NWAVES * 64), LDS_BYTES, stream, a); }
#else
    a.ph_lo = 0; a.ph_hi = NPHASES;
    hipLaunchKernelGGL(fwd_kernel, dim3(grid), dim3(NWAVES * 64), LDS_BYTES, stream, a);
#endif
}
```

```cpp
#include <hip/hip_runtime.h>
#include <cstdio>
#include <cstdint>
#include <cmath>
constexpr int NB = 8, T = 2048, D = 1024, CT = 256, ML = NB * T, MC = NB * CT, MR = ML + MC, TT = T + CT;
constexpr int INC = 3600, NQ = 3584;
constexpr int FF = 2816, FFE = 3584, NE = 8;
constexpr int ADA_LD = 6144, ADA_L = 9 * ADA_LD;
constexpr float EPS = 1e-6f, LOG2E = 1.4426950408889634f;
constexpr float QSCALE = 0.125f * LOG2E;
namespace pg8 {
#define PG8_LAS __attribute__((address_space(3)))
typedef unsigned short bf16_t;
typedef short bf16x8 __attribute__((ext_vector_type(8)));
typedef float f32x4 __attribute__((ext_vector_type(4)));
typedef unsigned u32x4 __attribute__((ext_vector_type(4)));
typedef int v4i_t __attribute__((ext_vector_type(4)));
typedef unsigned u32x2 __attribute__((ext_vector_type(2)));
typedef int v8i_t __attribute__((ext_vector_type(8)));
constexpr int BM = 256, BK = 64, HALF = 128, HTB = HALF * BK * 2  , STAGE_BYTES = 8 * HTB, NXCD = 8, WGM = 8;

__host__ __device__ __forceinline__ int lds_byte(int r, int c) { const int st = (r >> 4) * 2 + (c >> 5), rr = r & 15, cc = c & 31, ob = rr * 64 + cc * 2; return st * 1024 + (ob ^ (((ob >> 9) & 1) << 5)); }
__host__ __device__ __forceinline__ void stage_rc(int b, int& R, int& C) { const int st = b / 1024, sb = b % 1024, swz = sb ^ (((sb >> 9) & 1) << 5); R = (st >> 1) * 16 + swz / 64; C = (st & 1) * 32 + (swz % 64) / 2; }
__host__ __device__ __forceinline__ int perm32(int rho) { const int n = rho >> 4, i = rho & 15; return 8 * (i >> 2) + 4 * n + (i & 3); }

struct Unit { int pm, pn, ko; };
struct Gemm { const bf16_t* A; const bf16_t* Bt; int M, N, K, ld; };

struct StaticOrder {
    int nM, nN, nwg, G, c;
    __host__ __device__ void init(int M, int N, int G_, int c_) { nM = M / BM; nN = N / BM; nwg = nM * nN; G = G_; c = c_; }
    __host__ __device__ bool next(int i, Unit& u) const {
        const long L = (long)i * G + c; if (L >= nwg) return false;
        int wgid = (int)L; { const int q = nwg / NXCD, r = nwg % NXCD, xcd = wgid % NXCD, off = wgid / NXCD; wgid = (xcd < r ? xcd * (q + 1) : r * (q + 1) + (xcd - r) * q) + off; }
        const int nig = WGM * nN, gid = wgid / nig, fm = gid * WGM, gsz = (nM - fm) < WGM ? (nM - fm) : WGM;
        u.pm = fm + ((wgid % nig) % gsz); u.pn = (wgid % nig) / gsz; u.ko = 0; return true;
    }
    __device__ __forceinline__ void a_ready(const Unit&) const {}
    __device__ __forceinline__ void done(const Unit&) const {}
};

__device__ __forceinline__ unsigned cvt_pk_bf16(float lo, float hi) { unsigned r; asm volatile("v_cvt_pk_bf16_f32 %0, %1, %2" : "=v"(r) : "v"(lo), "v"(hi)); return r; }
typedef float f32x2 __attribute__((ext_vector_type(2)));
typedef float f32x2_t __attribute__((ext_vector_type(2))); typedef __bf16 bf16x2_t __attribute__((ext_vector_type(2)));
__device__ __forceinline__ unsigned pk2(float lo, float hi) { f32x2_t v = {lo, hi}; bf16x2_t b = __builtin_convertvector(v, bf16x2_t); return __builtin_bit_cast(unsigned, b); }
__device__ __forceinline__ u32x4 pk8(const f32x4 a, const f32x4 b) { u32x4 w; w.x = pk2(a[0], a[1]); w.y = pk2(a[2], a[3]); w.z = pk2(b[0], b[1]); w.w = pk2(b[2], b[3]); return w; }

struct EpiQKV {
    static constexpr bool PERM = true, AFTER_DRAIN = false;
    bf16_t* O; const float* qg; const float* kg; const float* ropeR; const float* ropeC;
    __device__ __forceinline__ void operator()(const f32x4 (&acc)[2][2][4][2], const Unit& u, int wr, int wc, int fr, int fq) const {
        const int row0 = u.pm * BM + wr * 64 + fr;
        if (u.pn >= 4) {
            const int col0 = u.pn * BM + wc * 32 + 8 * fq;
#pragma unroll
            for (int ai = 0; ai < 2; ++ai)
#pragma unroll
                for (int m = 0; m < 4; ++m) { bf16_t* rowp = O + (size_t)(row0 + ai * HALF + m * 16) * NQ + col0;
#pragma unroll
                    for (int bj = 0; bj < 2; ++bj) *(u32x4*)(rowp + bj * HALF) = pk8(acc[ai][bj][m][0], acc[ai][bj][m][1]); }
            return;
        }
        const bool isq = u.pn < 2; const float* gp = (isq ? qg : kg) + 8 * fq; const float qs = isq ? QSCALE : 1.0f;
        const int col0 = u.pn * BM + 64 * wc + 8 * fq;
#pragma unroll
        for (int ai = 0; ai < 2; ++ai)
#pragma unroll
            for (int m = 0; m < 4; ++m) {
                const int row = row0 + ai * HALF + m * 16;
                float ss = 0.f;
#pragma unroll
                for (int bj = 0; bj < 2; ++bj)
#pragma unroll
                    for (int n = 0; n < 2; ++n) { const f32x4 x = acc[ai][bj][m][n]; ss += (x[0] * x[0] + x[1] * x[1]) + (x[2] * x[2] + x[3] * x[3]); }
                ss += __shfl_xor(ss, 16); ss += __shfl_xor(ss, 32);
                const float rstd = 1.0f / sqrtf(ss * (1.0f / 64.0f) + EPS);
                f32x4 y[2][2];
#pragma unroll
                for (int bj = 0; bj < 2; ++bj)
#pragma unroll
                    for (int n = 0; n < 2; ++n) y[bj][n] = acc[ai][bj][m][n] * (rstd * qs) * *(const f32x4*)(gp + 32 * bj + 4 * n);
                if (row < ML) {
                    const int t = row & (T - 1);
                    const float* tab = (fq < 2) ? (ropeR + (t >> 6) * 32) : (ropeC + (t & 63) * 32);
                    tab += 2 * ((fq & 1) * 8);
#pragma unroll
                    for (int n = 0; n < 2; ++n) {
                        const f32x4 t0 = *(const f32x4*)(tab + 8 * n), t1 = *(const f32x4*)(tab + 8 * n + 4);
                        const f32x4 c = {t0[0], t0[2], t1[0], t1[2]}, s = {t0[1], t0[3], t1[1], t1[3]};
                        const f32x4 x1 = y[0][n], x2 = y[1][n];
                        y[0][n] = x1 * c - x2 * s; y[1][n] = x1 * s + x2 * c;
                    }
                }
                bf16_t* rowp = O + (size_t)row * NQ + col0;
#pragma unroll
                for (int bj = 0; bj < 2; ++bj) *(u32x4*)(rowp + 32 * bj) = pk8(y[bj][0], y[bj][1]);
            }
    }
};

template <bool BASEBF, bool OUTBF> struct EpiRes {
    static constexpr bool PERM = OUTBF, AFTER_DRAIN = false;
    const void* baseL; const void* baseC; void* out; const float* gate;
    __device__ __forceinline__ void operator()(const f32x4 (&acc)[2][2][4][2], const Unit& u, int wr, int wc, int fr, int fq) const {
        const int row0 = u.pm * BM + wr * 64 + fr, col0 = u.pn * BM + wc * 32 + (OUTBF ? 8 : 4) * fq;
#pragma unroll
        for (int ai = 0; ai < 2; ++ai)
#pragma unroll
            for (int m = 0; m < 4; ++m) {
                const int row = row0 + ai * HALF + m * 16;
                const int bsel = row < ML ? (row >> 11) : 8;
                const size_t boff = (row < ML ? (size_t)row * D : (size_t)(row - ML) * D) + col0; const void* bb = row < ML ? baseL : baseC;
                const float* gp = gate + bsel * ADA_LD + col0;
#pragma unroll
                for (int bj = 0; bj < 2; ++bj) {
                    if (OUTBF) {
                        f32x4 b0, b1;
                        if (BASEBF) { const u32x4 r = *(const u32x4*)((const bf16_t*)bb + boff + bj * HALF);
                            b0 = (f32x4){__uint_as_float(r[0] << 16), __uint_as_float(r[0] & 0xffff0000u), __uint_as_float(r[1] << 16), __uint_as_float(r[1] & 0xffff0000u)};
                            b1 = (f32x4){__uint_as_float(r[2] << 16), __uint_as_float(r[2] & 0xffff0000u), __uint_as_float(r[3] << 16), __uint_as_float(r[3] & 0xffff0000u)}; }
                        else { b0 = *(const f32x4*)((const float*)bb + boff + bj * HALF); b1 = *(const f32x4*)((const float*)bb + boff + bj * HALF + 4); }
                        const f32x4 v0 = b0 + *(const f32x4*)(gp + bj * HALF) * acc[ai][bj][m][0], v1 = b1 + *(const f32x4*)(gp + bj * HALF + 4) * acc[ai][bj][m][1];
                        *(u32x4*)((bf16_t*)out + (size_t)row * D + col0 + bj * HALF) = pk8(v0, v1);
                    } else {
#pragma unroll
                        for (int n = 0; n < 2; ++n) { const int o = bj * HALF + n * 16; f32x4 b;
                            if (BASEBF) { const unsigned long long r = *(const unsigned long long*)((const bf16_t*)bb + boff + o); const unsigned lo = (unsigned)r, hi = (unsigned)(r >> 32);
                                b = (f32x4){__uint_as_float(lo << 16), __uint_as_float(lo & 0xffff0000u), __uint_as_float(hi << 16), __uint_as_float(hi & 0xffff0000u)}; }
                            else b = *(const f32x4*)((const float*)bb + boff + o);
                            *(f32x4*)((float*)out + (size_t)row * D + col0 + o) = b + *(const f32x4*)(gp + o) * acc[ai][bj][m][n]; }
                    }
                }
            }
    }
};

__device__ __forceinline__ unsigned pk4_f8(const f32x4 v) {
    unsigned p = 0u;
    p = __builtin_amdgcn_cvt_pk_fp8_f32(__builtin_amdgcn_fmed3f(v[0], -448.f, 448.f), __builtin_amdgcn_fmed3f(v[1], -448.f, 448.f), p, false);
    p = __builtin_amdgcn_cvt_pk_fp8_f32(__builtin_amdgcn_fmed3f(v[2], -448.f, 448.f), __builtin_amdgcn_fmed3f(v[3], -448.f, 448.f), p, true);
    return p;
}
__device__ __forceinline__ f32x4 silu_mul_sc(const f32x4 a, const f32x4 b, float ke, float km) {
    f32x4 r;
#pragma unroll
    for (int i = 0; i < 4; ++i) r[i] = (a[i] * b[i]) * (km * __builtin_amdgcn_rcpf(1.0f + __builtin_amdgcn_exp2f(ke * a[i])));
    return r;
}
__device__ __forceinline__ f32x4 silu_mul(const f32x4 a, const f32x4 b) {
    f32x4 r;
#pragma unroll
    for (int i = 0; i < 4; ++i) r[i] = a[i] * __builtin_amdgcn_rcpf(1.0f + __builtin_amdgcn_exp2f(-LOG2E * a[i])) * b[i];
    return r;
}
template <bool OUT8> struct EpiGated {
    static constexpr bool PERM = true, AFTER_DRAIN = false;
    bf16_t* O; int ldc; int ntile; float sc, osc;
    __device__ __forceinline__ void operator()(const f32x4 (&acc)[2][2][4][2], const Unit& u, int wr, int wc, int fr, int fq) const {
        const int row0 = u.pm * BM + wr * 64 + fr, col0 = (u.pn % ntile) * HALF + wc * 32 + 8 * fq;
#pragma unroll
        for (int ai = 0; ai < 2; ++ai)
#pragma unroll
            for (int m = 0; m < 4; ++m) {
                const float ke = -LOG2E * sc, km = sc * sc * (OUT8 ? osc : 1.0f);
                const f32x4 v0 = silu_mul_sc(acc[ai][0][m][0], acc[ai][1][m][0], ke, km), v1 = silu_mul_sc(acc[ai][0][m][1], acc[ai][1][m][1], ke, km);
                if (OUT8) { u32x2 w8; w8.x = pk4_f8(v0); w8.y = pk4_f8(v1); *(u32x2*)((unsigned char*)O + (size_t)(row0 + ai * HALF + m * 16) * ldc + col0) = w8; }
                else *(u32x4*)(O + (size_t)(row0 + ai * HALF + m * 16) * ldc + col0) = pk8(v0, v1);
            }
    }
};
struct EpiScatter {
    static constexpr bool PERM = true, AFTER_DRAIN = false;
    bf16_t* Y; const int* rowmap; const float* roww; int sub; float sc;
    __device__ __forceinline__ void operator()(const f32x4 (&acc)[2][2][4][2], const Unit& u, int wr, int wc, int fr, int fq) const {
        const int row0 = u.pm * BM + wr * 64 + fr, col0 = (u.pn & 3) * BM + wc * 32 + 8 * fq;
#pragma unroll
        for (int ai = 0; ai < 2; ++ai)
#pragma unroll
            for (int m = 0; m < 4; ++m) {
                const int r = row0 + ai * HALF + m * 16; const int ts = rowmap[r];
                if (ts >= 0) { const float w = roww[r] * sc; bf16_t* rowp = Y + (size_t)(ts - sub) * D + col0;
#pragma unroll
                    for (int bj = 0; bj < 2; ++bj) *(u32x4*)(rowp + bj * HALF) = pk8(acc[ai][bj][m][0] * w, acc[ai][bj][m][1] * w); }
            }
    }
};
struct EpiScatterTail {
    static constexpr bool PERM = true, AFTER_DRAIN = false;
    bf16_t* YT; const float* roww; int kbytes; float sc;
    __device__ __forceinline__ void operator()(const f32x4 (&acc)[2][2][4][2], const Unit& u, int wr, int wc, int fr, int fq) const {
        const int row0 = u.pm * BM + wr * 64 + fr, col0 = (u.pn & 3) * BM + wc * 32 + 8 * fq; const int kq = u.ko / kbytes;
#pragma unroll
        for (int ai = 0; ai < 2; ++ai)
#pragma unroll
            for (int m = 0; m < 4; ++m) {
                const int r = row0 + ai * HALF + m * 16; const float w = roww[r] * sc; bf16_t* rowp = YT + ((size_t)kq * 2048 + (r - 64 * 256)) * D + col0;
#pragma unroll
                for (int bj = 0; bj < 2; ++bj) *(u32x4*)(rowp + bj * HALF) = pk8(acc[ai][bj][m][0] * w, acc[ai][bj][m][1] * w);
            }
    }
};
struct MoeOrder {
    const PG8_LAS int* tstart; int nN, G, c, maxpm;
    __device__ __forceinline__ bool next(int i, Unit& u) const {
        const int L = i * G + c; int T = tstart[8]; T = T < maxpm ? T : maxpm;
        const int nb = (T & ~7) * nN; int pm, j;
        if (L < nb) { const int b = L >> 5, r = L & 31, q4 = nN >> 2, g = b / q4; pm = 8 * g + (r & 7); j = 4 * (b - g * q4) + (r >> 3); }
        else { const int L2 = L - nb; pm = (T & ~7) + L2 / nN; j = L2 - (L2 / nN) * nN; }
        if (pm >= T) return false;
        int e = 0;
#pragma unroll
        for (int k = 1; k < 8; ++k) e += (pm >= tstart[k]) ? 1 : 0;
        u.pm = pm; u.pn = e * nN + j; u.ko = 0; return true;
    }
    __device__ __forceinline__ void a_ready(const Unit&) const {}
    __device__ __forceinline__ void done(const Unit&) const {}
};
struct MoeTailOrder {
    const PG8_LAS int* tstart; int G, c, pm0, kbytes, TS;
    __device__ __forceinline__ bool next(int i, Unit& u) const {
        const int L = i * G + c, t = L / TS, pm = pm0 + (t >> 2);
        if (pm >= tstart[8]) return false;
        int e = 0;
#pragma unroll
        for (int k = 1; k < 8; ++k) e += (pm >= tstart[k]) ? 1 : 0;
        u.pm = pm; u.pn = e * 4 + (t & 3); u.ko = (L - t * TS) * kbytes; return true;
    }
    __device__ __forceinline__ void a_ready(const Unit&) const {}
    __device__ __forceinline__ void done(const Unit&) const {}
};
template <class Epi, class Sched, bool ALIGN_EPI = false, bool SP2 = false, bool F8 = false>
__device__ __forceinline__ void gemm_phase(PG8_LAS unsigned char* lds, const Gemm g, const Sched& S, const Epi& E) {
    int tid_ = threadIdx.x; asm volatile("" : "+v"(tid_));
    const int tid = tid_, wid = __builtin_amdgcn_readfirstlane(tid >> 6), lane = tid & 63, wr = wid >> 2, wc = wid & 3, fr = lane & 15, fq = lane >> 4;
    const int K = g.ld, nt = g.K / BK;
    unsigned voffA[2], voffB[2];
#pragma unroll
    for (int i = 0; i < 2; ++i) { int R, C; stage_rc(tid * 16 + i * 8192, R, C); const int Rb = Epi::PERM ? ((R & ~31) + perm32(R & 31)) : R;
        voffA[i] = (unsigned)(R * K + C) * 2u; voffB[i] = (unsigned)(Rb * K + C) * 2u; }
    const size_t kstep = (size_t)(BK * 2);
    const size_t hstep = (size_t)HALF * K * 2;
    const size_t tstep = 2 * hstep;
    const unsigned ldsw = (unsigned)wid * 1024u;
    const int aoff = lds_byte(wr * 64 + fr, fq * 8), boff = lds_byte(wc * 32 + fr, fq * 8);
    int a8[2], b8[2];
#pragma unroll
    for (int p = 0; p < 2; ++p) { a8[p] = lds_byte(wr * 64 + fr, (fq >> 1) * 32 + 16 * (fq & 1) + 8 * p); b8[p] = lds_byte(wc * 32 + fr, (fq >> 1) * 32 + 16 * (fq & 1) + 8 * p); }
#define PG8_SA(b, h) (((b) * 2 + (h)) * HTB)
#define PG8_SB(b, h) ((4 + (b) * 2 + (h)) * HTB)
#define PG8_STAGE(bufoff, gbase, voff) do { _Pragma("unroll") for (int _i = 0; _i < 2; ++_i) \
        __builtin_amdgcn_global_load_lds((const unsigned*)((const char*)(gbase) + (voff)[_i]), (PG8_LAS unsigned*)(lds + (bufoff) + ldsw + _i * 8192), 16, 0, 0); } while (0)
#define PG8_LDA(dst, b, h) do { if constexpr (F8) { _Pragma("unroll") for (int m = 0; m < 4; ++m) dst##8[m] = *(const PG8_LAS v8i_t*)(lds + PG8_SA(b, h) + a8[0] + m * 2048); }     \
    else { _Pragma("unroll") for (int m = 0; m < 4; ++m) _Pragma("unroll") for (int k = 0; k < 2; ++k) dst[m][k] = *(const PG8_LAS bf16x8*)(lds + PG8_SA(b, h) + aoff + m * 2048 + k * 1024); } } while (0)
#define PG8_LDB(dst, b, h) do { if constexpr (F8) { _Pragma("unroll") for (int n = 0; n < 2; ++n) dst##8[n] = *(const PG8_LAS v8i_t*)(lds + PG8_SB(b, h) + b8[0] + n * 2048); } \
    else { _Pragma("unroll") for (int n = 0; n < 2; ++n) _Pragma("unroll") for (int k = 0; k < 2; ++k) dst[n][k] = *(const PG8_LAS bf16x8*)(lds + PG8_SB(b, h) + boff + n * 2048 + k * 1024); } } while (0)
#define PG8_CAT8(x0, x1) __builtin_shufflevector(__builtin_bit_cast(v4i_t, x0), __builtin_bit_cast(v4i_t, x1), 0, 1, 2, 3, 4, 5, 6, 7)
#define PG8_MMA(ai, bj, At, Bt) do { __builtin_amdgcn_s_setprio(1); if constexpr (F8) { _Pragma("unroll") for (int m = 0; m < 4; ++m) _Pragma("unroll") for (int n = 0; n < 2; ++n) \
        asm volatile("v_mfma_f32_16x16x128_f8f6f4 %0, %1, %2, %0" : "+v"(acc[ai][bj][m][n]) : "v"(Bt##8[n]), "v"(At##8[m])); } \
    else { _Pragma("unroll") for (int m = 0; m < 4; ++m) _Pragma("unroll") for (int n = 0; n < 2; ++n) _Pragma("unroll") for (int k = 0; k < 2; ++k) \
        acc[ai][bj][m][n] = __builtin_amdgcn_mfma_f32_16x16x32_bf16(Bt[n][k], At[m][k], acc[ai][bj][m][n], 0, 0, 0); } __builtin_amdgcn_s_setprio(0); } while (0)
#define PG8_WAIT_V(n) asm volatile("s_waitcnt vmcnt(" #n ")" ::: "memory")
#define PG8_WAIT_L(n) asm volatile("s_waitcnt lgkmcnt(" #n ")" ::: "memory")
#define PG8_BAR __builtin_amdgcn_s_barrier()
#define PG8_SCHED __builtin_amdgcn_sched_barrier(0)
    Unit cur, nxt; int ui = 0;
    if (!S.next(0, cur)) return;
    f32x4 acc[2][2][4][2];
#pragma unroll
    for (int a = 0; a < 2; ++a)
#pragma unroll
        for (int b = 0; b < 2; ++b)
#pragma unroll
            for (int m = 0; m < 4; ++m)
#pragma unroll
                for (int n = 0; n < 2; ++n) acc[a][b][m][n] = (f32x4){0.f, 0.f, 0.f, 0.f};
    bf16x8 At[4][2], B0[2][2], B1[2][2]; v8i_t At8[4], B08[2], B18[2];
    const char* cA = (const char*)g.A + (size_t)cur.pm * tstep + cur.ko; const char* cB = (const char*)g.Bt + (size_t)cur.pn * tstep + cur.ko;
    S.a_ready(cur);
    if constexpr (SP2) {
        PG8_STAGE(PG8_SB(0, 0), cB, voffB); PG8_STAGE(PG8_SB(0, 1), cB + hstep, voffB); PG8_STAGE(PG8_SA(0, 0), cA, voffA); PG8_STAGE(PG8_SA(0, 1), cA + hstep, voffA);
        if (wr == 1) PG8_BAR;
        PG8_WAIT_V(2); PG8_BAR;
        PG8_STAGE(PG8_SB(1, 0), cB + kstep, voffB); PG8_STAGE(PG8_SA(1, 0), cA + kstep, voffA); PG8_STAGE(PG8_SB(1, 1), cB + hstep + kstep, voffB);
        PG8_WAIT_V(6); PG8_BAR;
    } else {
        PG8_STAGE(PG8_SB(0, 0), cB, voffB); PG8_STAGE(PG8_SA(0, 0), cA, voffA); PG8_STAGE(PG8_SB(0, 1), cB + hstep, voffB); PG8_STAGE(PG8_SA(0, 1), cA + hstep, voffA);
        if (wr == 1) PG8_BAR;
        PG8_WAIT_V(4); PG8_BAR;
        PG8_STAGE(PG8_SB(1, 0), cB + kstep, voffB); PG8_STAGE(PG8_SA(1, 0), cA + kstep, voffA); PG8_STAGE(PG8_SB(1, 1), cB + hstep + kstep, voffB);
        PG8_WAIT_V(6); PG8_BAR;
    }
    for (;;) {
        const bool has_next = S.next(ui + 1, nxt);
        const char* nA = has_next ? (const char*)g.A + (size_t)nxt.pm * tstep + nxt.ko : cA; const char* nB = has_next ? (const char*)g.Bt + (size_t)nxt.pn * tstep + nxt.ko : cB;
        for (int t = 0; t < nt; t += 2) {
            const bool last = (t == nt - 2);
            const char* a1 = cA + (size_t)(t + 1) * kstep;
            const char* a2 = last ? nA : cA + (size_t)(t + 2) * kstep; const char* b2 = last ? nB : cB + (size_t)(t + 2) * kstep;
            const char* a3 = a2 + kstep; const char* b3 = b2 + kstep;
            if (last && has_next) S.a_ready(nxt);
            if constexpr (SP2) {
            PG8_LDB(B0, 0, 0); PG8_LDB(B1, 0, 1); PG8_SCHED; PG8_LDA(At, 0, 0); PG8_STAGE(PG8_SA(1, 1), a1 + hstep, voffA);
            PG8_WAIT_V(8); PG8_WAIT_L(0); PG8_BAR; PG8_MMA(0, 0, At, B0); PG8_MMA(0, 1, At, B1); PG8_BAR; PG8_SCHED;
            PG8_LDA(At, 0, 1); PG8_STAGE(PG8_SB(0, 0), b2, voffB); PG8_STAGE(PG8_SB(0, 1), b2 + hstep, voffB); PG8_STAGE(PG8_SA(0, 0), a2, voffA);
            PG8_WAIT_V(8); PG8_WAIT_L(0); PG8_BAR; PG8_MMA(1, 0, At, B0); PG8_MMA(1, 1, At, B1); PG8_BAR; PG8_SCHED;
            PG8_LDB(B0, 1, 0); PG8_LDB(B1, 1, 1); PG8_SCHED; PG8_LDA(At, 1, 0); PG8_STAGE(PG8_SA(0, 1), a2 + hstep, voffA);
            PG8_WAIT_V(8); PG8_WAIT_L(0); PG8_BAR; PG8_MMA(0, 0, At, B0); PG8_MMA(0, 1, At, B1); PG8_BAR; PG8_SCHED;
            PG8_LDA(At, 1, 1); PG8_STAGE(PG8_SB(1, 0), b3, voffB); PG8_STAGE(PG8_SB(1, 1), b3 + hstep, voffB); PG8_STAGE(PG8_SA(1, 0), a3, voffA);
            PG8_WAIT_V(8); PG8_WAIT_L(0); PG8_BAR; PG8_MMA(1, 0, At, B0); PG8_MMA(1, 1, At, B1); PG8_BAR; PG8_SCHED;
            } else {
            PG8_LDB(B0, 0, 0); PG8_SCHED; PG8_LDA(At, 0, 0); PG8_STAGE(PG8_SA(1, 1), a1 + hstep, voffA);
            PG8_WAIT_L(8); PG8_BAR; PG8_WAIT_L(0); PG8_MMA(0, 0, At, B0); PG8_BAR; PG8_SCHED;
            PG8_LDB(B1, 0, 1); PG8_STAGE(PG8_SB(0, 0), b2, voffB);
            PG8_BAR; PG8_WAIT_L(0); PG8_MMA(0, 1, At, B1); PG8_BAR;
            PG8_LDA(At, 0, 1); PG8_STAGE(PG8_SA(0, 0), a2, voffA);
            PG8_BAR; PG8_WAIT_L(0); PG8_MMA(1, 0, At, B0); PG8_BAR; PG8_SCHED;
            PG8_STAGE(PG8_SB(0, 1), b2 + hstep, voffB);
            PG8_WAIT_V(6); PG8_BAR; PG8_MMA(1, 1, At, B1); PG8_BAR;
            PG8_LDB(B0, 1, 0); PG8_SCHED; PG8_LDA(At, 1, 0); PG8_STAGE(PG8_SA(0, 1), a2 + hstep, voffA);
            PG8_WAIT_L(8); PG8_BAR; PG8_WAIT_L(0); PG8_MMA(0, 0, At, B0); PG8_BAR; PG8_SCHED;
            PG8_LDB(B1, 1, 1); PG8_STAGE(PG8_SB(1, 0), b3, voffB);
            PG8_BAR; PG8_WAIT_L(0); PG8_MMA(0, 1, At, B1); PG8_BAR;
            PG8_LDA(At, 1, 1); PG8_STAGE(PG8_SA(1, 0), a3, voffA);
            PG8_BAR; PG8_WAIT_L(0); PG8_MMA(1, 0, At, B0); PG8_BAR; PG8_SCHED;
            PG8_STAGE(PG8_SB(1, 1), b3 + hstep, voffB);
            PG8_WAIT_V(6); PG8_BAR; PG8_MMA(1, 1, At, B1); PG8_BAR;
            }
        }
        if constexpr (F8) asm volatile("s_nop 15\n\ts_nop 7" ::: "memory");
        if constexpr (ALIGN_EPI) { if (wr == 0) PG8_BAR; }
        if constexpr (!Epi::AFTER_DRAIN) { E(acc, cur, wr, wc, fr, fq); S.done(cur); }
        if (!has_next) break;
#pragma unroll
        for (int a = 0; a < 2; ++a)
#pragma unroll
            for (int b = 0; b < 2; ++b)
#pragma unroll
                for (int m = 0; m < 4; ++m)
#pragma unroll
                    for (int n = 0; n < 2; ++n) acc[a][b][m][n] = (f32x4){0.f, 0.f, 0.f, 0.f};
        cur = nxt; cA = nA; cB = nB; ++ui;
        if constexpr (ALIGN_EPI) { if (wr == 1) PG8_BAR; }
    }
    PG8_WAIT_V(0);
    if constexpr (!ALIGN_EPI) { if (wr == 0) PG8_BAR; }
    PG8_BAR;
    if constexpr (Epi::AFTER_DRAIN) { E.fused(acc, cur, wr, wc, fr, fq, lds, wid, lane); S.done(cur); }
#undef PG8_SA
#undef PG8_SB
#undef PG8_STAGE
#undef PG8_LDA
#undef PG8_LDB
#undef PG8_MMA
#undef PG8_CAT8
#undef PG8_WAIT_V
#undef PG8_WAIT_L
#undef PG8_BAR
#undef PG8_SCHED
}
}
#ifndef PG8_SP2
#define PG8_SP2 true
#endif
#ifndef PG8_ALIGN
#define PG8_ALIGN true
#endif
#ifndef MK_PER_PHASE
#define MK_PER_PHASE 0
#endif
constexpr size_t MiB = 1u << 20;
constexpr size_t WS_CTL = 0, CTL_ZERO_BYTES = 64 * 1024;
constexpr size_t WS_ADA = 1 * MiB;
constexpr size_t WS_SMALL = 2 * MiB;
constexpr size_t WS_GATES = 4 * MiB;
constexpr size_t WS_SCAN = 6 * MiB;
constexpr size_t WS_WIN = 8 * MiB;
constexpr size_t WS_WOUT = 22 * MiB;
constexpr size_t WS_WUP = 26 * MiB;
constexpr size_t WS_WDN = 37 * MiB;
constexpr size_t WS_MUP = 43 * MiB;
constexpr size_t WS_MDN = 155 * MiB;
constexpr size_t WS_XA = 211 * MiB;
constexpr size_t WS_Y = 247 * MiB;
constexpr size_t WS_QKV = 283 * MiB;
constexpr size_t WS_CAT = 409 * MiB;
constexpr size_t WS_H = 445 * MiB;
constexpr size_t WS_DC = 481 * MiB;
constexpr size_t WS_END = 517 * MiB;
constexpr size_t SM_ROPE = 0;
constexpr size_t SM_ROUTE = 16384;
constexpr size_t SM_ROWMAP = SM_ROUTE + (size_t)ML * 32;
constexpr size_t SM_ROWW = SM_ROWMAP + 2 * (size_t)MR * 4;
constexpr size_t SM_GTAB = 1280 * 1024;
constexpr size_t SM_RTAB = SM_GTAB + 2 * 16 * 1024 * 4;
static_assert(SM_ROWW + 2 * (size_t)MR * 4 <= SM_GTAB && SM_RTAB + 8 * 1024 * 4 <= 2 * MiB, "WS_SMALL map");
constexpr int SC_N = 2 * NB * 4 * TT;
constexpr int SC_ROW = 0, SC_COL = SC_N, SC_LMX = 2 * SC_N, SC_DN = 2 * SC_N + 1024;
constexpr int CW_CNT = 1024;
constexpr int CW_CVQ = 1536;
constexpr int CW_BAR = 4096;
static_assert((CW_BAR + 3456) * 4 <= (int)CTL_ZERO_BYTES, "control words inside the memset region");

constexpr int RING_BYTES = 131072;
constexpr int LDSCTL_OFF = RING_BYTES, MISC_OFF = LDSCTL_OFF + 320;
constexpr int SMALL_OFF = RING_BYTES + 1024;
constexpr int LDS_BYTES = 147456;
constexpr int NWAVES = 8;

#define GAS __attribute__((address_space(1)))
#define LAS __attribute__((address_space(3)))
#define DI __device__ __forceinline__
typedef unsigned short bf16;
typedef float f32x4 __attribute__((ext_vector_type(4)));
typedef float f32x16 __attribute__((ext_vector_type(16)));
typedef short bf16x8 __attribute__((ext_vector_type(8)));
typedef short s16x4 __attribute__((ext_vector_type(4)));
typedef unsigned u32x4 __attribute__((ext_vector_type(4)));
using pg8::u32x2;
typedef GAS unsigned gu32;
#define RLX_AGENT __ATOMIC_RELAXED, __HIP_MEMORY_SCOPE_AGENT
#define LDS_WAIT() asm volatile("s_waitcnt lgkmcnt(0)" ::: "memory")
using pg8::pk2;
DI float bf2f(unsigned h) { return __uint_as_float(h << 16); }
constexpr float F8_SA = 16.0f, F8_SW = 512.0f, F8_SH = 8.0f;
DI float f8clamp(float x) { return fminf(fmaxf(x, -448.0f), 448.0f); }
DI unsigned pk4_f8(float a, float b, float c, float d) { unsigned p = 0u; p = __builtin_amdgcn_cvt_pk_fp8_f32(f8clamp(a), f8clamp(b), p, false); p = __builtin_amdgcn_cvt_pk_fp8_f32(f8clamp(c), f8clamp(d), p, true); return p; }
DI float wave_sum(float v) {
#pragma unroll
    for (int o = 1; o < 64; o <<= 1) v += __shfl_xor(v, o);
    return v;
}
DI float wave_max(float v) {
#pragma unroll
    for (int o = 1; o < 64; o <<= 1) v = fmaxf(v, __shfl_xor(v, o));
    return v;
}

#define XB_TMO      128
#define XB_XCNT(j)  (256  + 64 * (j))
#define XB_XSUB(j)  (1280 + 64 * (j))
#define XB_XGEN(j)  (2304 + 64 * (j))
#define XB_TOP      3328
#define XB_TOPGEN   3392
#define XCD_BAR_WORDS 3456
#define XB_SPIN_CAP (1u << 18)
__device__ __forceinline__ unsigned xb_ld(unsigned* p)              { return __hip_atomic_load(p, __ATOMIC_RELAXED, __HIP_MEMORY_SCOPE_AGENT); }
__device__ __forceinline__ unsigned xb_add(unsigned* p, unsigned v) { return __hip_atomic_fetch_add(p, v, __ATOMIC_RELAXED, __HIP_MEMORY_SCOPE_AGENT); }
__device__ __forceinline__ unsigned xb_xcc_id() { return (unsigned)__builtin_amdgcn_s_getreg((3 << 11) | 20) & 0xFu; }
#define XB_SPIN(cond, bar) do { unsigned _sp = 0; while (cond) { __builtin_amdgcn_s_sleep(1); \
    if ((++_sp & 255u) == 0u) { if (xb_ld(&(bar)[XB_TMO])) break; if (_sp > XB_SPIN_CAP) { atomicAdd(&(bar)[XB_TMO], 1u); break; } } } } while (0)
struct XcdBarrier { unsigned* bar; unsigned x; volatile LAS unsigned* st; };
__device__ __forceinline__ XcdBarrier xcd_barrier_post(unsigned* bar, volatile LAS unsigned* st) {
    XcdBarrier b; b.bar = bar; b.x = xb_xcc_id(); b.st = st;
    if (threadIdx.x == 0) (void)xb_add(&bar[XB_XCNT(b.x)], 1u);
    return b;
}
__device__ __forceinline__ void xcd_barrier_complete(unsigned* bar, unsigned x, unsigned& nloc, unsigned& nx) {
    const unsigned G = gridDim.x * gridDim.y * gridDim.z;
    unsigned sum, cnt, mine, sp = 0u;
    for (;;) {
        sum = 0u; cnt = 0u; mine = 0u;
#pragma unroll
        for (unsigned j = 0; j < 16; ++j) { const unsigned c = xb_ld(&bar[XB_XCNT(j)]); sum += c; cnt += (c > 0u) ? 1u : 0u; mine = (j == x) ? c : mine; }
        if (sum == G) break;
        __builtin_amdgcn_s_sleep(1);
        if ((++sp & 255u) == 0u) { if (xb_ld(&bar[XB_TMO])) break; if (sp > XB_SPIN_CAP) { atomicAdd(&bar[XB_TMO], 1u); break; } }
    }
    nloc = mine > 0u ? mine : 1u; nx = cnt > 0u ? cnt : 1u;
}
__device__ __forceinline__ void xcd_barrier(const XcdBarrier& b) {
    asm volatile("s_waitcnt vmcnt(0)" ::: "memory");
    __syncthreads();
    if (threadIdx.x == 0) {
        unsigned* bar = b.bar;
        __builtin_amdgcn_s_waitcnt(0);
        unsigned nloc = b.st[0], nx = b.st[1];
        if (nloc == 0u) { xcd_barrier_complete(bar, b.x, nloc, nx); b.st[0] = nloc; b.st[1] = nx; }
        const unsigned old = xb_add(&bar[XB_XSUB(b.x)], 1u);
        const unsigned gen = old / nloc;
        if (old + 1u == (gen + 1u) * nloc) {
            __builtin_amdgcn_fence(__ATOMIC_RELEASE, "agent");
            asm volatile("s_waitcnt vmcnt(0)" ::: "memory");
            const unsigned og = xb_add(&bar[XB_TOP], 1u);
            const unsigned tg = og / nx;
            if (og + 1u == (tg + 1u) * nx) xb_add(&bar[XB_TOPGEN], 1u);
            else XB_SPIN(xb_ld(&bar[XB_TOPGEN]) == tg, bar);
            __builtin_amdgcn_fence(__ATOMIC_ACQUIRE, "agent");
            xb_add(&bar[XB_XGEN(b.x)], 1u);
            asm volatile("s_waitcnt vmcnt(0)" ::: "memory");
        } else {
            XB_SPIN(xb_ld(&bar[XB_XGEN(b.x)]) == gen, bar);
            __builtin_amdgcn_fence(__ATOMIC_ACQUIRE, "agent");
            asm volatile("s_waitcnt vmcnt(0)" ::: "memory");
        }
    }
    __syncthreads();
}

struct Args { const float* in[28]; float* out; unsigned char* ws; int ph_lo, ph_hi; };
typedef const Args __attribute__((address_space(4)))* KArgs;
DI KArgs kargs() { KArgs p = (KArgs)__builtin_amdgcn_kernarg_segment_ptr(); asm volatile("" : "+s"(p)); return p; }
struct Frame {
    LAS unsigned char* lds;
    int tid, lane, wave, vcu, G;
};
DI Frame fresh(const Frame& F0) { Frame F = F0; int l = (int)__builtin_amdgcn_mbcnt_hi(~0u, __builtin_amdgcn_mbcnt_lo(~0u, 0u)); asm volatile("" : "+v"(l)); F.lane = l; F.tid = F.wave * 64 + l; return F; }
enum { I_X = 0, I_C, I_CTX, I_CCTX, I_ADAW, I_ADAB, I_N1G, I_N2G, I_WIN, I_WOUT, I_QNG, I_KNG, I_LQ1, I_LK1, I_LQ2, I_LK2, I_SUBLN, I_CONVW, I_CONVB, I_GATEB, I_MNG,
       I_FW1, I_FW3, I_FW2, I_RW, I_MW1, I_MW3, I_MW2 };

template <bool NT = false, bool F8OUT = false>
DI void tr_item(const float* W, int ldw, int K, bf16* WT, int k0, int n0, int drow0, LAS float* scr, int lane) {
#pragma unroll 8
    for (int i = 0; i < 32; ++i) { const int kk = 2 * i + (lane >> 5); const float* src = &W[(size_t)(k0 + kk) * ldw + n0 + (lane & 31)]; scr[kk * 33 + (lane & 31)] = NT ? __builtin_nontemporal_load(src) : *src; }
    LDS_WAIT(); asm volatile("" ::: "memory");
    const int c = lane & 7;
#pragma unroll
    for (int j = 0; j < 4; ++j) { const int n = (lane >> 3) + 8 * j; const LAS float* s = scr + (8 * c) * 33 + n;
        if (F8OUT) {
            u32x2 o; o.x = pk4_f8(s[0 * 33] * F8_SW, s[1 * 33] * F8_SW, s[2 * 33] * F8_SW, s[3 * 33] * F8_SW); o.y = pk4_f8(s[4 * 33] * F8_SW, s[5 * 33] * F8_SW, s[6 * 33] * F8_SW, s[7 * 33] * F8_SW);
            u32x2* dst = (u32x2*)((unsigned char*)WT + (size_t)(drow0 + n) * K + k0 + 8 * c);
            if (NT) __builtin_nontemporal_store(o, dst); else *dst = o;
        } else {
        u32x4 o; o.x = pk2(s[0 * 33], s[1 * 33]); o.y = pk2(s[2 * 33], s[3 * 33]); o.z = pk2(s[4 * 33], s[5 * 33]); o.w = pk2(s[6 * 33], s[7 * 33]);
        u32x4* dst = (u32x4*)(WT + (size_t)(drow0 + n) * K + k0 + 8 * c);
        if (NT) __builtin_nontemporal_store(o, dst); else *dst = o; } }
    LDS_WAIT(); asm volatile("" ::: "memory");
}
DI int map_win(int n0) {
    if (n0 >= 1024) return n0;
    const int pn = n0 >> 8, o = n0 & 255, g = o >> 6, d = o & 63;
    return (pn << 8) + 128 * (d >> 5) + 32 * g;
}
DI int map_up(int n0, int third) { return 256 * (n0 >> 7) + 128 * third + (n0 & 127); }
constexpr int CV_IN = 16 * 112, CV_OUT = 16 * 32, CV_UP = 16 * 88, CV_DN = 44 * 32, CV_M13 = 16 * 112, CV_M2 = 56 * 32;
constexpr int CV_PRO = 2 * CV_IN + 2 * CV_OUT + 2 * CV_UP + CV_DN + 8300, CV_P4 = CV_PRO + 7500, CV_P6 = CV_P4 + 8400;
constexpr int CV_SMALL = 2 * CV_IN + 2 * CV_OUT + 2 * CV_UP + CV_DN, CV_ALL = CV_SMALL + 16 * CV_M13 + 8 * CV_M2;
DI void cvt_item(const KArgs ka, int it, LAS float* scr, int lane) {
    unsigned char* ws = ka->ws;
    int r = it;
    if (r < 2 * CV_IN) { const int l = r / CV_IN; r -= l * CV_IN; const int kb = r / 112, nb = r % 112;
        tr_item(ka->in[I_WIN] + (size_t)l * 1024 * INC, INC, 1024, (bf16*)(ws + WS_WIN) + (size_t)l * NQ * 1024, 64 * kb, 32 * nb, map_win(32 * nb), scr, lane); return; } r -= 2 * CV_IN;
    if (r < 2 * CV_OUT) { const int l = r / CV_OUT; r -= l * CV_OUT; const int kb = r / 32, nb = r % 32;
        tr_item(ka->in[I_WOUT] + (size_t)l * 1024 * 1024, 1024, 1024, (bf16*)(ws + WS_WOUT) + (size_t)l * 1024 * 1024, 64 * kb, 32 * nb, 32 * nb, scr, lane); return; } r -= 2 * CV_OUT;
    if (r < 2 * CV_UP) { const int th = r / CV_UP; r -= th * CV_UP; const int kb = r / 88, nb = r % 88;
        tr_item(ka->in[th ? I_FW3 : I_FW1], FF, 1024, (bf16*)(ws + WS_WUP), 64 * kb, 32 * nb, map_up(32 * nb, th), scr, lane); return; } r -= 2 * CV_UP;
    if (r < CV_DN) { const int kb = r / 32, nb = r % 32;
        tr_item(ka->in[I_FW2], 1024, FF, (bf16*)(ws + WS_WDN), 64 * kb, 32 * nb, 32 * nb, scr, lane); return; } r -= CV_DN;
    if (r < 16 * CV_M13) { const int th = r / (8 * CV_M13); r -= th * 8 * CV_M13; const int e = r / CV_M13; r -= e * CV_M13; const int kb = r / 112, nb = r % 112;
        tr_item<true, true>(ka->in[th ? I_MW3 : I_MW1] + (size_t)e * 1024 * FFE, FFE, 1024, (bf16*)(ws + WS_MUP), 64 * kb, 32 * nb, e * 2 * FFE + map_up(32 * nb, th), scr, lane); return; } r -= 16 * CV_M13;
    { const int e = r / CV_M2; r -= e * CV_M2; const int kb = r / 32, nb = r % 32;
        tr_item<true, true>(ka->in[I_MW2] + (size_t)e * FFE * 1024, 1024, FFE, (bf16*)(ws + WS_MDN), 64 * kb, 32 * nb, e * 1024 + 32 * nb, scr, lane); }
}
DI void p0_prologue(const Frame& F) {
    const KArgs ka = kargs(); unsigned char* ws = ka->ws;
    {
        LAS float* S = (LAS float*)F.lds;
        LAS float* P = (LAS float*)(F.lds + 36864);
        bool have = false;
        for (int it = F.vcu; it < 192; it += F.G) {
            if (!have) {
                for (int idx = F.tid; idx < 9 * 1024; idx += NWAVES * 64) { const int r = idx >> 10, i = idx & 1023; const float v = r < 8 ? ka->in[I_C][r * 1024 + i] : ka->in[I_CCTX][i]; S[idx] = v / (1.0f + expf(-v)); }
                __syncthreads(); have = true;
            }
            const int l = it / 96, col = (it % 96) * 64 + F.lane;
            const float* w = ka->in[I_ADAW] + (size_t)l * 1024 * ADA_LD + col;
            float acc[9];
#pragma unroll
            for (int r = 0; r < 9; ++r) acc[r] = 0.f;
            const int kb = F.wave * 128;
#pragma unroll 16
            for (int k = 0; k < 128; ++k) { const float wv = w[(size_t)(kb + k) * ADA_LD];
#pragma unroll
                for (int r = 0; r < 9; ++r) acc[r] += S[r * 1024 + kb + k] * wv; }
#pragma unroll
            for (int r = 0; r < 9; ++r) P[(F.wave * 9 + r) * 64 + F.lane] = acc[r];
            __syncthreads();
            for (int idx = F.tid; idx < 9 * 64; idx += NWAVES * 64) { const int r = idx >> 6, ln = idx & 63; float s = 0.f;
#pragma unroll
                for (int w8 = 0; w8 < 8; ++w8) s += P[(w8 * 9 + r) * 64 + ln];
                const int c2 = (it % 96) * 64 + ln;
                ((float*)(ws + WS_ADA))[l * ADA_L + r * ADA_LD + c2] = s + ka->in[I_ADAB][l * ADA_LD + c2]; }
            __syncthreads();
        }
        __syncthreads();
    }
    if (F.vcu >= 1 && F.vcu <= 5) {
        float* gt = (float*)(ws + WS_SMALL + SM_GTAB); float* rt = (float*)(ws + WS_SMALL + SM_RTAB);
        for (int idx = (F.vcu - 1) * NWAVES * 64 + F.tid; idx < 2 * 16384 + 8192; idx += 5 * NWAVES * 64) {
            if (idx < 2 * 16384) { const int l = idx >> 14, k = (idx >> 4) & 1023, g = idx & 15; gt[l * 16384 + g * 1024 + k] = ka->in[I_WIN][(size_t)l * 1024 * INC + (size_t)k * INC + NQ + g]; }
            else { const int r = idx - 2 * 16384, k = r >> 3, e = r & 7; rt[e * 1024 + k] = ka->in[I_RW][k * NE + e]; }
        }
    }
    if (F.vcu == 0) {
        float* rr = (float*)(ws + WS_SMALL + SM_ROPE);
        for (int idx = F.tid; idx < 96 * 16; idx += NWAVES * 64) { const int p = idx >> 4, i = idx & 15;
            const float inv = exp2f(-(float)i * (13.287712379549449f / 16.0f)); const float pos = (float)(p < 32 ? p : p - 32); const float ang = pos * inv;
            rr[p * 32 + 2 * i] = cosf(ang); rr[p * 32 + 2 * i + 1] = sinf(ang); }
    }
    LAS float* scr = (LAS float*)(F.lds + F.wave * 16384);
    const int gw = F.vcu * NWAVES + F.wave, NGW = F.G * NWAVES;
    constexpr int CV_HEAD = 2048;
    if (F.G > 192 && F.vcu >= 192) for (int it = (F.vcu - 192) * NWAVES + F.wave; it < CV_HEAD; it += (F.G - 192) * NWAVES) cvt_item(ka, it, scr, F.lane);
    for (int it = (F.G > 192 ? CV_HEAD : 0) + gw; it < CV_PRO; it += NGW) cvt_item(ka, it, scr, F.lane);
}
DI void idle_convert(const Frame& F, int nunits, int lo, int hi) {
    const int r = nunits % F.G, c = (int)blockIdx.x;
    if (r == 0 || c < r) return;
    const KArgs ka = kargs();
    LAS float* scr = (LAS float*)(F.lds + F.wave * 16384);
    const int gw = (c - r) * NWAVES + F.wave, NGW = (F.G - r) * NWAVES;
    for (int it = lo + gw; it < hi; it += NGW) cvt_item(ka, it, scr, F.lane);
}
template <int NV, int SH, int N> DI void bfly_step(float (&part)[N], int lane) {
    const bool up = (lane & SH) != 0;
#pragma unroll
    for (int g = 0; g < NV; ++g) { const float keep = up ? part[g + NV] : part[g], give = up ? part[g] : part[g + NV]; part[g] = keep + __shfl_xor(give, SH); }
}
template <int KIND, bool SRCBF>
DI void modulate_phase(const Frame& F, const void* srcL, const void* srcC, int nrows, const float* gam, const float* ada  , int off_sh, int off_sc,
                       bf16* H, const float* wtab  , float* gates, unsigned char* ws,
                       const bf16* extraC = nullptr  , bf16* wbC = nullptr  ) {
    constexpr int NT = KIND == 0 ? 16 : (KIND == 2 ? 8 : 0);
    LAS float* tab = (LAS float*)F.lds;
    if (NT) {
        for (int idx = F.tid; idx < NT * 256; idx += NWAVES * 64) *(LAS f32x4*)(tab + 4 * idx) = *(const f32x4*)(wtab + 4 * idx);
        __syncthreads();
    }
    const int gw = F.vcu * NWAVES + F.wave, NGW = F.G * NWAVES;
    LAS unsigned* lc = (LAS unsigned*)(F.lds + SMALL_OFF + 256);
    LAS unsigned* rl = (LAS unsigned*)(F.lds + SMALL_OFF + 512);
    if (KIND == 2) { int t_ = F.tid; asm volatile("" : "+v"(t_)); if (t_ < 32) lc[t_] = 0u; __syncthreads(); }
    int kk = 0;
    f32x4 nxt[4];
#define MOD_LOAD(r_) do { const int r2_ = (r_) < nrows ? (r_) : gw; const size_t ro_ = (r2_ < ML ? (size_t)r2_ * D : (size_t)(r2_ - ML) * D) + 4 * F.lane; const void* sb_ = r2_ < ML ? srcL : srcC; \
        _Pragma("unroll") for (int j = 0; j < 4; ++j) { if (SRCBF) { const u32x2 r_2 = *(const u32x2*)((const bf16*)sb_ + ro_ + 256 * j); \
                nxt[j] = (f32x4){__uint_as_float(r_2.x << 16), __uint_as_float(r_2.x & 0xffff0000u), __uint_as_float(r_2.y << 16), __uint_as_float(r_2.y & 0xffff0000u)}; } \
            else nxt[j] = *(const f32x4*)((const float*)sb_ + ro_ + 256 * j); } } while (0)
    if (gw < nrows) MOD_LOAD(gw);
    for (int row = gw; row < nrows; row += NGW, ++kk) {
        const int bsel = row < ML ? (row >> 11) : 8;
        const float* sh = ada + bsel * ADA_LD + off_sh + 4 * F.lane; const float* sc = ada + bsel * ADA_LD + off_sc + 4 * F.lane; const float* gm = gam + 4 * F.lane;
        f32x4 v[4]; float ss = 0.f;
#pragma unroll
        for (int j = 0; j < 4; ++j) v[j] = nxt[j];
        MOD_LOAD(row + NGW);
        if (extraC && row >= ML) {
#pragma unroll
            for (int j = 0; j < 4; ++j) { const u32x2 e2 = *(const u32x2*)(extraC + (size_t)(row - ML) * D + 4 * F.lane + 256 * j);
                v[j] = v[j] + (f32x4){__uint_as_float(e2.x << 16), __uint_as_float(e2.x & 0xffff0000u), __uint_as_float(e2.y << 16), __uint_as_float(e2.y & 0xffff0000u)};
                if (wbC) { u32x2 w2; w2.x = pk2(v[j][0], v[j][1]); w2.y = pk2(v[j][2], v[j][3]); *(u32x2*)(wbC + (size_t)(row - ML) * D + 4 * F.lane + 256 * j) = w2; } }
        }
#pragma unroll
        for (int j = 0; j < 4; ++j) ss += (v[j][0] * v[j][0] + v[j][1] * v[j][1]) + (v[j][2] * v[j][2] + v[j][3] * v[j][3]);
        const float rstd = 1.0f / sqrtf(wave_sum(ss) * (1.0f / D) + EPS);
#pragma unroll
        for (int j = 0; j < 4; ++j) { const f32x4 g4 = *(const f32x4*)(gm + 256 * j), s4 = *(const f32x4*)(sc + 256 * j), h4 = *(const f32x4*)(sh + 256 * j);
            v[j] = v[j] * rstd * g4 * (s4 + 1.0f) + h4; }
        if (KIND == 2) {
#pragma unroll
            for (int j = 0; j < 4; ++j) *(unsigned*)((unsigned char*)H + (size_t)row * D + 4 * F.lane + 256 * j) = pk4_f8(v[j][0] * F8_SA, v[j][1] * F8_SA, v[j][2] * F8_SA, v[j][3] * F8_SA);
        } else {
        u32x2* o8 = (u32x2*)(H + (size_t)row * D) + F.lane;
#pragma unroll
        for (int j = 0; j < 4; ++j) { u32x2 w; w.x = pk2(v[j][0], v[j][1]); w.y = pk2(v[j][2], v[j][3]); o8[64 * j] = w; }
        }
        if (NT) {
            float part[NT > 0 ? NT : 1];
#pragma unroll
            for (int g = 0; g < NT; ++g) { float s = 0.f;
#pragma unroll
                for (int j = 0; j < 4; ++j) { const f32x4 w4 = *(const LAS f32x4*)(tab + g * 1024 + 4 * F.lane + 256 * j); s += (v[j][0] * w4[0] + v[j][1] * w4[1]) + (v[j][2] * w4[2] + v[j][3] * w4[3]); }
                part[g] = s;
                if ((g & 3) == 3) asm volatile("" : "+v"(part[g - 3]), "+v"(part[g - 2]), "+v"(part[g - 1]), "+v"(part[g])); }
            bfly_step<(NT >> 1), 32, (NT > 0 ? NT : 1)>(part, F.lane);
            bfly_step<(NT >> 2), 16, (NT > 0 ? NT : 1)>(part, F.lane);
            bfly_step<(NT >> 3), 8, (NT > 0 ? NT : 1)>(part, F.lane);
            if (NT == 16) bfly_step<1, 4, (NT > 0 ? NT : 1)>(part, F.lane);
            float mine = part[0];
#pragma unroll
            for (int o = (NT == 16 ? 2 : 4); o >= 1; o >>= 1) mine += __shfl_xor(mine, o);
            if (KIND == 0) {
                const int gidx = ((F.lane >> 5) & 1) * 8 + ((F.lane >> 4) & 1) * 4 + ((F.lane >> 3) & 1) * 2 + ((F.lane >> 2) & 1);
                if ((F.lane & 3) == 0) gates[(size_t)row * 16 + gidx] = mine;
            } else {
                const int eidx = ((F.lane >> 5) & 1) * 4 + ((F.lane >> 4) & 1) * 2 + ((F.lane >> 3) & 1);
                float v0 = mine; int i0 = eidx;
#pragma unroll
                for (int o = 8; o < 64; o <<= 1) { const float ov = __shfl_xor(v0, o); const int oi = __shfl_xor(i0, o); if (ov > v0 || (ov == v0 && oi < i0)) { v0 = ov; i0 = oi; } }
                float v1 = (eidx == i0) ? -INFINITY : mine; int i1 = eidx;
#pragma unroll
                for (int o = 8; o < 64; o <<= 1) { const float ov = __shfl_xor(v1, o); const int oi = __shfl_xor(i1, o); if (ov > v1 || (ov == v1 && oi < i1)) { v1 = ov; i1 = oi; } }
                if (F.lane == 0) {
                    const float w0 = 1.0f / (1.0f + expf(v1 - v0)), w1 = 1.0f - w0;
                    const int half = row >> 13;
                    unsigned p0, p1;
                    if (kk < 16) { p0 = __hip_atomic_fetch_add(lc + half * 8 + i0, 1u, __ATOMIC_RELAXED, __HIP_MEMORY_SCOPE_WORKGROUP); p1 = __hip_atomic_fetch_add(lc + half * 8 + i1, 1u, __ATOMIC_RELAXED, __HIP_MEMORY_SCOPE_WORKGROUP);
                        LAS unsigned* r = rl + (F.wave * 16 + kk) * 8; r[0] = (unsigned)i0; r[1] = (unsigned)i1; r[2] = p0; r[3] = p1; r[4] = __float_as_uint(w0); r[5] = __float_as_uint(w1); }
                    else { unsigned* cnt = (unsigned*)(ws + WS_CTL) + CW_CNT + half * 8; p0 = atomicAdd(cnt + i0, 1u); p1 = atomicAdd(cnt + i1, 1u);
                        u32x4* rec = (u32x4*)(ws + WS_SMALL + SM_ROUTE + (size_t)row * 32);
                        rec[0] = (u32x4){(unsigned)i0, (unsigned)i1, p0, p1}; rec[1] = (u32x4){__float_as_uint(w0), __float_as_uint(w1), 0u, 0u}; }
                }
            }
        }
    }
#undef MOD_LOAD
    if (KIND == 2) {
        __syncthreads();
        if (F.tid < 16) lc[16 + F.tid] = atomicAdd((unsigned*)(ws + WS_CTL) + CW_CNT + F.tid, lc[F.tid]);
        __syncthreads();
        if (F.lane == 0) { int k2 = 0;
            for (int row = gw; row < nrows && k2 < 16; row += NGW, ++k2) { const LAS unsigned* r = rl + (F.wave * 16 + k2) * 8; const int half = row >> 13;
                u32x4* rec = (u32x4*)(ws + WS_SMALL + SM_ROUTE + (size_t)row * 32);
                rec[0] = (u32x4){r[0], r[1], r[2] + lc[16 + half * 8 + r[0]], r[3] + lc[16 + half * 8 + r[1]]}; rec[1] = (u32x4){r[4], r[5], 0u, 0u}; } }
    }
}

DI void conv_phase(const Frame& F, const bf16* QKV, bf16* MQK, const float* cw, const float* cb) {
    const int tg = F.tid >> 6, cg = F.tid & 63;
    for (int it = F.vcu; it < MR / 64; it += F.G) {
        const int c0 = 8 * cg;
        const int r0 = it * 64 + tg * 8;
        const int seqlen = r0 < ML ? T : CT, sbase = r0 < ML ? (r0 & ~(T - 1)) : ML + ((r0 - ML) & ~(CT - 1));
        const int t0 = r0 - sbase;
        u32x4 raw[12];
#pragma unroll
        for (int j = 0; j < 12; ++j) { const int t = t0 - 2 + j; const bool inr = t >= 0 && t < seqlen; const int tc = t < 0 ? 0 : (t >= seqlen ? seqlen - 1 : t);
            raw[j] = *(const u32x4*)(QKV + (size_t)(sbase + tc) * NQ + 1536 + c0); if (!inr) raw[j] = (u32x4){0u, 0u, 0u, 0u}; }
        const float osc = c0 >= 512 ? 0.08838834764831845f : 1.0f;
        float acc[8][8];
        { const f32x4 a = *(const f32x4*)(cb + c0), b = *(const f32x4*)(cb + c0 + 4);
#pragma unroll
          for (int k = 0; k < 8; ++k)
#pragma unroll
              for (int i = 0; i < 4; ++i) { acc[k][i] = a[i]; acc[k][4 + i] = b[i]; } }
#pragma unroll
        for (int j = 0; j < 5; ++j) {
            const f32x4 wa = *(const f32x4*)(cw + j * 1024 + c0), wb = *(const f32x4*)(cw + j * 1024 + c0 + 4);
#pragma unroll
            for (int k = 0; k < 8; ++k) { const u32x4 r = raw[k + j];
#pragma unroll
                for (int i = 0; i < 4; ++i) { const float wl = i < 2 ? wa[2 * i] : wb[2 * i - 4], wh = i < 2 ? wa[2 * i + 1] : wb[2 * i - 3];
                    acc[k][2 * i] += wl * bf2f(r[i] & 0xffffu); acc[k][2 * i + 1] += wh * bf2f(r[i] >> 16); } }
        }
#pragma unroll
        for (int k = 0; k < 8; ++k) { float y[8];
#pragma unroll
            for (int i = 0; i < 8; ++i) { const float sv = acc[k][i]; y[i] = sv * __builtin_amdgcn_rcpf(1.0f + __builtin_amdgcn_exp2f(-LOG2E * sv)) * osc; }
            u32x4 o; o.x = pk2(y[0], y[1]); o.y = pk2(y[2], y[3]); o.z = pk2(y[4], y[5]); o.w = pk2(y[6], y[7]);
            *(u32x4*)(MQK + (size_t)(r0 + k) * D + c0) = o; }
    }
}
DI float log_sigmoid(float g) { return fminf(g, 0.f) - log1pf(expf(-fabsf(g))); }
DI void scan_phase(const Frame& F, const float* gates, const float* gb  , float* scan) {
    LAS float* xs = (LAS float*)(F.lds + SMALL_OFF + 512);
    const int hw = F.wave >> 2, w4 = F.wave & 3, t256 = F.tid & 255;
    for (int it = F.vcu; it < 32; it += F.G) {
        const int ch = 2 * it + hw;
        const int dir = ch >> 5, b = (ch >> 2) & 7, h = ch & 3;
        const float bi = gb[dir * 8 + h], bf_ = gb[dir * 8 + 4 + h];
        const int gi = dir * 8 + h, gf = dir * 8 + 4 + h;
        float li[9], lf[9]; float tot = 0.f, lmx = 0.f;
#pragma unroll
        for (int k = 0; k < 9; ++k) { const int p = 9 * t256 + k;
            int row; if (dir == 0) row = p < CT ? ML + b * CT + p : b * T + (p - CT); else row = p < T ? b * T + p : ML + b * CT + (p - T);
            li[k] = gates[(size_t)row * 16 + gi] + bi; lf[k] = gates[(size_t)row * 16 + gf] + bf_; }
#pragma unroll
        for (int k = 0; k < 9; ++k) { lf[k] = log_sigmoid(lf[k]); tot += lf[k]; lmx = fmaxf(lmx, li[k]); }
        lmx = wave_max(lmx);
        float incl = tot;
#pragma unroll
        for (int o = 1; o < 64; o <<= 1) { const float n = __shfl_up(incl, o); if (F.lane >= o) incl += n; }
        if (F.lane == 63) xs[(hw * 4 + w4) * 2] = incl;
        if (F.lane == 0) xs[(hw * 4 + w4) * 2 + 1] = lmx;
        __syncthreads();
        float run = incl - tot;
#pragma unroll
        for (int w = 0; w < 4; ++w) { if (w < w4) run += xs[(hw * 4 + w) * 2]; lmx = fmaxf(lmx, xs[(hw * 4 + w) * 2 + 1]); }
        float* ROW = scan + SC_ROW + (size_t)ch * TT; float* COL = scan + SC_COL + (size_t)ch * TT;
#pragma unroll
        for (int k = 0; k < 9; ++k) { const int p = 9 * t256 + k;
            const int u = dir == 0 ? p : (p < T ? CT + p : p - T);
            if (dir == 0) { run += lf[k]; ROW[u] = run * LOG2E; COL[u] = (run - li[k] + lmx) * LOG2E; }
            else { ROW[u] = -run * LOG2E; COL[u] = (-run - li[k] + lmx) * LOG2E; run += lf[k]; } }
        if (t256 == 0) scan[SC_LMX + ch] = lmx;
        __syncthreads();
    }
}

DI s16x4 vtr_(const LAS unsigned char* p) { typedef short v4i16_t __attribute__((ext_vector_type(4))); return __builtin_bit_cast(s16x4, __builtin_amdgcn_ds_read_tr16_b64_v4i16((LAS v4i16_t*)p)); }
DI void mstate_unit(const Frame& F, const bf16* QKV, bf16* MQK, const float* scan, const float* cw  , const float* cb, float* DC, int b, int h, int k, int dir) {
    const int tid = F.tid, lane = F.lane, wid = F.wave, hi = lane >> 5;
    LAS unsigned char* lds = F.lds;
    const int c16 = tid & 15, tgrp = tid >> 4;
    const int ch0 = h * 128 + 8 * c16;
    const int seqrow0 = k == 0 ? ML + b * CT : b * T, seqlen = k == 0 ? CT : T, tchunk = k == 0 ? 0 : 256 * (k - 1);
    const int chn = dir * 32 + b * 4 + h;
    const float ref = scan[SC_ROW + (size_t)chn * TT + 256 * k + (dir ? 0 : 255)];
    const float* cwk = cw + 512 + ch0; const float* cbk = cb + 512 + ch0;
    const bool wrk = dir == 0 || k == 8;
    const int dkb = wid & 3, dvg = wid >> 2;
    f32x16 acc[3];
#pragma unroll
    for (int d = 0; d < 3; ++d)
#pragma unroll
        for (int i = 0; i < 16; ++i) acc[d][i] = 0.f;
    const unsigned vbn = ((lane >> 4) & 1) * 32 + (lane & 3) * 8 + (8 * hi + ((lane & 15) >> 2)) * 64;
    f32x4 wa[5], wb[5], ba, bb;
#pragma unroll
    for (int j = 0; j < 5; ++j) { wa[j] = *(const f32x4*)(cwk + j * 1024); wb[j] = *(const f32x4*)(cwk + j * 1024 + 4); }
    ba = *(const f32x4*)cbk; bb = *(const f32x4*)(cbk + 4);
#pragma unroll 1
    for (int sub = 0; sub < 2; ++sub) {
        const int tl0 = 128 * sub + 4 * tgrp;
        u32x4 raw[8], vv[4];
#pragma unroll
        for (int j = 0; j < 8; ++j) { const int t = tchunk + tl0 - 2 + j; const int tc = t < 0 ? 0 : (t >= seqlen ? seqlen - 1 : t);
            raw[j] = *(const u32x4*)(QKV + (size_t)(seqrow0 + tc) * NQ + 2048 + ch0); if (t < 0 || t >= seqlen) raw[j] = (u32x4){0u, 0u, 0u, 0u}; }
#pragma unroll
        for (int q = 0; q < 4; ++q) vv[q] = *(const u32x4*)(QKV + (size_t)(seqrow0 + tchunk + tl0 + q) * NQ + 2560 + ch0);
        const f32x4 col4 = *(const f32x4*)(scan + SC_COL + (size_t)chn * TT + 256 * k + tl0);
#pragma unroll
        for (int q = 0; q < 4; ++q) {
            float y[8];
#pragma unroll
            for (int i = 0; i < 4; ++i) { y[i] = ba[i]; y[4 + i] = bb[i]; }
#pragma unroll
            for (int j = 0; j < 5; ++j)
#pragma unroll
                for (int i = 0; i < 8; ++i) { const unsigned rw = raw[q + j][i >> 1]; y[i] += (i < 4 ? wa[j][i] : wb[j][i - 4]) * bf2f((i & 1) ? (rw >> 16) : (rw & 0xffffu)); }
#pragma unroll
            for (int i = 0; i < 8; ++i) { const float sv = y[i]; y[i] = sv * __builtin_amdgcn_rcpf(1.0f + __builtin_amdgcn_exp2f(-LOG2E * sv)) * 0.08838834764831845f; }
            if (wrk) { u32x4 ok; ok.x = pk2(y[0], y[1]); ok.y = pk2(y[2], y[3]); ok.z = pk2(y[4], y[5]); ok.w = pk2(y[6], y[7]); *(u32x4*)(MQK + (size_t)(seqrow0 + tchunk + tl0 + q) * D + 512 + ch0) = ok; }
            const float us = __builtin_amdgcn_exp2f(ref - col4[q]);
            u32x4 of;
#pragma unroll
            for (int i = 0; i < 4; ++i) of[i] = pk2(y[2 * i] * us, y[2 * i + 1] * us);
            const unsigned ka = (c16 >> 2) * 8192 + (4 * tgrp + q) * 64 + (c16 & 3) * 16;
            *(LAS u32x4*)(lds + ka) = of; *(LAS u32x4*)(lds + 32768 + ka) = vv[q];
        }
        { const int tok = tid >> 2, pc = tid & 3;
          *(LAS u32x4*)(lds + 32768 + 4 * 8192 + tok * 64 + pc * 16) = (u32x4){pc == 0 ? 0x3F80u : 0u, 0u, 0u, 0u}; }
        __syncthreads();
        const LAS unsigned char* Kb_ = lds + dkb * 8192 + vbn; const LAS unsigned char* Vb_ = lds + 32768 + vbn;
#pragma unroll 2
        for (int ks = 0; ks < 8; ++ks) {
            const s16x4 al = vtr_(Kb_ + ks * 1024), ah = vtr_(Kb_ + ks * 1024 + 256);
            const bf16x8 af = __builtin_shufflevector(al, ah, 0, 1, 2, 3, 4, 5, 6, 7);
#pragma unroll
            for (int d = 0; d < 3; ++d) { const int blk = dvg == 0 ? (d == 2 ? 4 : d) : (d == 2 ? 3 : 2 + d);
                if (dvg == 1 && d == 2) continue;
                const s16x4 bl = vtr_(Vb_ + blk * 8192 + ks * 1024), bh = vtr_(Vb_ + blk * 8192 + ks * 1024 + 256);
                acc[d] = __builtin_amdgcn_mfma_f32_32x32x16_bf16(af, __builtin_shufflevector(bl, bh, 0, 1, 2, 3, 4, 5, 6, 7), acc[d], 0, 0, 0); }
        }
        __syncthreads();
    }
    const int r32 = lane & 31;
    float* dc = DC + ((size_t)(chn * 9 + k) << 14);
    float* dn = (float*)scan + SC_DN + (chn * 9 + k) * 128;
#pragma unroll
    for (int i = 0; i < 16; ++i) { const int dk = 32 * dkb + (i & 3) + 8 * (i >> 2) + 4 * hi;
        if (dvg == 0) { dc[dk * 128 + r32] = acc[0][i]; dc[dk * 128 + 32 + r32] = acc[1][i]; if (r32 == 0) dn[dk] = acc[2][i]; }
        else { dc[dk * 128 + 64 + r32] = acc[0][i]; dc[dk * 128 + 96 + r32] = acc[1][i]; } }
}
DI void mprefix_phase(const Frame& F, float* scan, float* DC) {
    for (int it = F.vcu; it < 256; it += F.G) {
        const int ch = it >> 2, part = it & 3, dir = ch >> 5;
        const float* ROW = scan + SC_ROW + (size_t)ch * TT;
        float* base = DC + ((size_t)(ch * 9) << 14) + part * 4096 + F.tid * 8;
        float* nb = scan + SC_DN + ch * 9 * 128 + (F.tid & 127);
        const bool don = part == 0 && F.tid < 128;
        f32x4 x0[9], x1[9]; float xn[9], G[9];
#pragma unroll
        for (int k = 0; k < 9; ++k) { const float* p = base + ((size_t)k << 14); x0[k] = *(const f32x4*)p; x1[k] = *(const f32x4*)(p + 4); xn[k] = don ? nb[k * 128] : 0.f; }
        if (dir == 0) {
#pragma unroll
            for (int k = 1; k < 8; ++k) G[k] = __builtin_amdgcn_exp2f(ROW[256 * k + 255] - ROW[256 * k - 1]);
#pragma unroll
            for (int k = 1; k < 8; ++k) { x0[k] = x0[k - 1] * G[k] + x0[k]; x1[k] = x1[k - 1] * G[k] + x1[k]; xn[k] = xn[k - 1] * G[k] + xn[k];
                float* p = base + ((size_t)k << 14); *(f32x4*)p = x0[k]; *(f32x4*)(p + 4) = x1[k]; if (don) nb[k * 128] = xn[k]; }
        } else {
#pragma unroll
            for (int k = 2; k < 9; ++k) G[k] = __builtin_amdgcn_exp2f(ROW[256 * k] - ROW[256 * (k == 8 ? 0 : k + 1)]);
#pragma unroll
            for (int k = 8; k >= 2; --k) { const int nx = k == 8 ? 0 : k + 1;
                x0[k] = x0[nx] * G[k] + x0[k]; x1[k] = x1[nx] * G[k] + x1[k]; xn[k] = xn[nx] * G[k] + xn[k];
                float* p = base + ((size_t)k << 14); *(f32x4*)p = x0[k]; *(f32x4*)(p + 4) = x1[k]; if (don) nb[k * 128] = xn[k]; }
        }
    }
}
DI int crow(int r, int hi) { return (r & 3) + 8 * (r >> 2) + 4 * hi; }
DI s16x4 vtr(const LAS unsigned char* p) { typedef short v4i16_t __attribute__((ext_vector_type(4))); return __builtin_bit_cast(s16x4, __builtin_amdgcn_ds_read_tr16_b64_v4i16((LAS v4i16_t*)p)); }
DI bf16x8 pack8(const f32x16& x, int s) {
    u32x4 p; p.x = pk2(x[8 * s], x[8 * s + 1]); p.y = pk2(x[8 * s + 2], x[8 * s + 3]); p.z = pk2(x[8 * s + 4], x[8 * s + 5]); p.w = pk2(x[8 * s + 6], x[8 * s + 7]);
    return __builtin_bit_cast(bf16x8, p);
}
struct MixArgs {
    const bf16* QKV; const bf16* MQK; bf16* CAT; const float* scan; const float* DC;
    const float* gain;
    float lam, post, negm;
};
template <int MODE>
DI void mix_unit(const Frame& F, const MixArgs& A, int b, int h, int qt, bool isctx) {
    constexpr int KS = MODE == 0 ? 4 : 8;
    int lane_ = F.lane; asm volatile("" : "+v"(lane_));
    const int lane = lane_, wid = F.wave, tid = wid * 64 + lane, r32 = lane & 31, hi = lane >> 5;
    const int side = MODE == 0 ? (wid & 1) : (wid >> 2), qblk = MODE == 0 ? (wid >> 1) : (wid & 3);
    LAS unsigned char* lds = F.lds;
    const int qrow0 = (isctx ? ML + b * CT : b * T) + 128 * qt + 32 * qblk;
    const int kq = isctx ? 0 : 1 + (qt >> 1);
    const int jlo = MODE == 0 ? (isctx ? 32 : 0) : 4 * kq, jhi = MODE == 0 ? 36 : 4 * kq + 4;
    const int jd = MODE == 1 ? ((isctx ? 0 : 4) + 2 * qt + (qblk >> 1)) : 0;
    const bf16* Ksrc = MODE == 0 ? A.QKV + 512 + h * 128 : A.MQK + 512 + h * 128; const int Kld = MODE == 0 ? NQ : D;
    const bf16* Vsrc = A.QKV + (MODE == 0 ? 1024 : 2560) + h * 128;
    const int key0 = tid >> 4, c16 = tid & 15;
    const unsigned kdst0 = c16 * 1024 + ((key0 ^ c16) << 4), kdst1 = c16 * 1024 + (((key0 + 32) ^ c16) << 4);
    const unsigned vdst0 = 16384 + (c16 >> 2) * 4096 + (key0 ^ (c16 >> 2)) * 64 + (c16 & 3) * 16, vdst1 = vdst0 + 32 * 64;
    const float* colsrc = A.scan + SC_COL + (size_t)((wid & 1) * 32 + b * 4 + h) * TT;
    const unsigned koff0 = (unsigned)(key0 * Kld + 8 * c16) * 2u, koff1 = koff0 + 64u * (unsigned)Kld, voff0 = (unsigned)(key0 * NQ + 8 * c16) * 2u, voff1 = voff0 + 64u * (unsigned)NQ;
#define TILE_ROW0(j) (MODE == 0 ? ((j) < 32 ? b * T + 64 * (j) : ML + b * CT + 64 * ((j) - 32)) : ((j) < 4 ? ML + b * CT + 64 * (j) : b * T + 64 * ((j) - 4)))
    bf16x8 qf[KS];
    const bf16* qbase = MODE == 0 ? A.QKV + (size_t)qrow0 * NQ + h * 128 + side * 64 : A.MQK + (size_t)qrow0 * D + h * 128;
    unsigned qoff = (unsigned)(r32 * (MODE == 0 ? NQ : D) + 8 * hi) * 2u;
#define LOAD_Q() do { _Pragma("unroll") for (int d0 = 0; d0 < KS; ++d0) qf[d0] = *(const bf16x8*)((const char*)qbase + qoff + 32 * d0); } while (0)
    if (MODE == 0) LOAD_Q();
    float rowv = 0.f;
    if (MODE == 1) rowv = A.scan[SC_ROW + (size_t)(side * 32 + b * 4 + h) * TT + (isctx ? 0 : CT) + 128 * qt + 32 * qblk + r32];
    f32x16 o[4];
#pragma unroll
    for (int d0 = 0; d0 < 4; ++d0)
#pragma unroll
        for (int i = 0; i < 16; ++i) o[d0][i] = 0.f;
    float lsum = 0.f;
    u32x4 kr0, kr1, vr0, vr1; float cr = 0.f;
#define LOAD_TILE(j) do { const int tr0_ = TILE_ROW0(j); const char* kt_ = (const char*)(Ksrc + (size_t)tr0_ * Kld); const char* vt_ = (const char*)(Vsrc + (size_t)tr0_ * NQ); \
        kr0 = *(const u32x4*)(kt_ + koff0); kr1 = *(const u32x4*)(kt_ + koff1); vr0 = *(const u32x4*)(vt_ + voff0); vr1 = *(const u32x4*)(vt_ + voff1); \
        if (MODE == 1 && wid < 2) cr = colsrc[(unsigned)(64 * (j) + lane)]; } while (0)
#define STORE_TILE(slot) do { LAS unsigned char* d_ = lds + (slot) * 32768; \
        *(LAS u32x4*)(d_ + kdst0) = kr0; *(LAS u32x4*)(d_ + kdst1) = kr1; *(LAS u32x4*)(d_ + vdst0) = vr0; *(LAS u32x4*)(d_ + vdst1) = vr1; \
        if (MODE == 1 && wid < 2) ((LAS float*)(lds + SMALL_OFF + 2048 + (slot) * 512))[tid] = cr; } while (0)
    const unsigned vb = ((lane >> 4) & 1) * 32 + (lane & 3) * 8 + (4 * hi + ((lane & 15) >> 2)) * 64;
#define QK_S(P0, P1, Kb_) do { float nm_ = MODE == 0 ? A.negm : 0.f; if (MODE == 0) asm volatile("" : "+v"(nm_));     \
        _Pragma("unroll") for (int i = 0; i < 16; ++i) { P0[i] = nm_; P1[i] = nm_; } \
        _Pragma("unroll") for (int d0 = 0; d0 < KS; ++d0) { const int ck = (MODE == 0 ? side * 8 : 0) + 2 * d0 + hi; \
            const bf16x8 k0 = *(const LAS bf16x8*)((Kb_) + ck * 1024 + ((r32 ^ ck) << 4)); const bf16x8 k1 = *(const LAS bf16x8*)((Kb_) + ck * 1024 + (((r32 + 32) ^ ck) << 4)); \
            P0 = __builtin_amdgcn_mfma_f32_32x32x16_bf16(k0, qf[d0], P0, 0, 0, 0); P1 = __builtin_amdgcn_mfma_f32_32x32x16_bf16(k1, qf[d0], P1, 0, 0, 0); } } while (0)
#define PV_LOADF(L, H, d0_) do { const LAS unsigned char* vp_ = vbase_ + (d0_) * 4096 + (vb ^ ((d0_) << 6)); \
        _Pragma("unroll") for (int ks = 0; ks < 4; ++ks) { L[ks] = vtr(vp_ + ks * 1024); H[ks] = vtr(vp_ + ks * 1024 + 512); } } while (0)
#define PV_MMA(L, H, d0_) do { \
        o[d0_] = __builtin_amdgcn_mfma_f32_32x32x16_bf16(pa0, __builtin_shufflevector(L[0], H[0], 0, 1, 2, 3, 4, 5, 6, 7), o[d0_], 0, 0, 0); o[d0_] = __builtin_amdgcn_mfma_f32_32x32x16_bf16(pa1, __builtin_shufflevector(L[1], H[1], 0, 1, 2, 3, 4, 5, 6, 7), o[d0_], 0, 0, 0); \
        o[d0_] = __builtin_amdgcn_mfma_f32_32x32x16_bf16(pa2, __builtin_shufflevector(L[2], H[2], 0, 1, 2, 3, 4, 5, 6, 7), o[d0_], 0, 0, 0); o[d0_] = __builtin_amdgcn_mfma_f32_32x32x16_bf16(pa3, __builtin_shufflevector(L[3], H[3], 0, 1, 2, 3, 4, 5, 6, 7), o[d0_], 0, 0, 0); } while (0)
#define PV_O1(P0, P1, Vb_) do { const LAS unsigned char* vbase_ = (Vb_); const bf16x8 pa0 = pack8(P0, 0), pa1 = pack8(P0, 1), pa2 = pack8(P1, 0), pa3 = pack8(P1, 1); \
        _Pragma("unroll") for (int d0 = 0; d0 < 4; ++d0) { s16x4 la[4], ha[4]; PV_LOADF(la, ha, d0); PV_MMA(la, ha, d0); } } while (0)
#define PV_LD2(L, H, d0_, k0_) do { const LAS unsigned char* vp_ = vbase_ + va[d0_]; \
        L[0] = vtr(vp_ + (k0_) * 1024); H[0] = vtr(vp_ + (k0_) * 1024 + 512); L[1] = vtr(vp_ + (k0_) * 1024 + 1024); H[1] = vtr(vp_ + (k0_) * 1024 + 1536); } while (0)
#define PV_MM2(L, H, d0_, PA, PB) do { \
        o[d0_] = __builtin_amdgcn_mfma_f32_32x32x16_bf16(PA, __builtin_shufflevector(L[0], H[0], 0, 1, 2, 3, 4, 5, 6, 7), o[d0_], 0, 0, 0); \
        o[d0_] = __builtin_amdgcn_mfma_f32_32x32x16_bf16(PB, __builtin_shufflevector(L[1], H[1], 0, 1, 2, 3, 4, 5, 6, 7), o[d0_], 0, 0, 0); } while (0)
#define PV_O(P0, P1, Vb_) do { const LAS unsigned char* vbase_ = (Vb_); s16x4 la[2], ha[2], lb[2], hb[2]; \
        PV_LD2(la, ha, 0, 0); PV_LD2(lb, hb, 0, 2); \
        const bf16x8 pa0 = pack8(P0, 0), pa1 = pack8(P0, 1), pa2 = pack8(P1, 0), pa3 = pack8(P1, 1); \
        __builtin_amdgcn_sched_barrier(0); PV_MM2(la, ha, 0, pa0, pa1); PV_LD2(la, ha, 1, 0); \
        __builtin_amdgcn_sched_barrier(0); PV_MM2(lb, hb, 0, pa2, pa3); PV_LD2(lb, hb, 1, 2); \
        __builtin_amdgcn_sched_barrier(0); PV_MM2(la, ha, 1, pa0, pa1); PV_LD2(la, ha, 2, 0); \
        __builtin_amdgcn_sched_barrier(0); PV_MM2(lb, hb, 1, pa2, pa3); PV_LD2(lb, hb, 2, 2); \
        __builtin_amdgcn_sched_barrier(0); PV_MM2(la, ha, 2, pa0, pa1); PV_LD2(la, ha, 3, 0); \
        __builtin_amdgcn_sched_barrier(0); PV_MM2(lb, hb, 2, pa2, pa3); PV_LD2(lb, hb, 3, 2); \
        __builtin_amdgcn_sched_barrier(0); PV_MM2(la, ha, 3, pa0, pa1); \
        __builtin_amdgcn_sched_barrier(0); PV_MM2(lb, hb, 3, pa2, pa3); } while (0)
#define QK0(P0, P1, Kb_) do { const LAS unsigned char* kb_ = (Kb_); \
        _Pragma("unroll") for (int d0 = 0; d0 < 4; ++d0) { const bf16x8 k0 = *(const LAS bf16x8*)(kb_ + ka[d0]), k1 = *(const LAS bf16x8*)(kb_ + ka[d0] + 512); \
            if (d0 == 0) { P0 = __builtin_amdgcn_mfma_f32_32x32x16_bf16(k0, qf[0], zero16, 0, 0, 0); P1 = __builtin_amdgcn_mfma_f32_32x32x16_bf16(k1, qf[0], zero16, 0, 0, 0); } \
            else { P0 = __builtin_amdgcn_mfma_f32_32x32x16_bf16(k0, qf[d0], P0, 0, 0, 0); P1 = __builtin_amdgcn_mfma_f32_32x32x16_bf16(k1, qf[d0], P1, 0, 0, 0); } } } while (0)
#define VFRG(k) (bf16x8){lo[k][0], lo[k][1], lo[k][2], lo[k][3], hh[k][0], hh[k][1], hh[k][2], hh[k][3]}
    if constexpr (MODE == 0) {
        const int nt = jhi - jlo, rot = isctx ? 0 : (qt * nt) >> 4;
        typedef float f32x2 __attribute__((ext_vector_type(2)));
        const f32x16 zero16 = {0.f, 0.f, 0.f, 0.f, 0.f, 0.f, 0.f, 0.f, 0.f, 0.f, 0.f, 0.f, 0.f, 0.f, 0.f, 0.f};
        unsigned ka[4], va[4];
#pragma unroll
        for (int d0 = 0; d0 < 4; ++d0) { const int ck = side * 8 + 2 * d0 + hi; ka[d0] = (unsigned)(ck * 1024 + ((r32 ^ ck) << 4)); va[d0] = (unsigned)(16384 + d0 * 4096) + (vb ^ (unsigned)(d0 << 6));
            asm volatile("" : "+v"(ka[d0]), "+v"(va[d0])); }
        const float negm = __builtin_bit_cast(float, __builtin_amdgcn_readfirstlane(__builtin_bit_cast(int, A.negm)));
        const bool shift = negm < -64.0f;
        f32x2 ls2 = {0.f, 0.f};
#define TJ(x) (jlo + (((x) - jlo + rot) >= nt ? ((x) - jlo + rot) - nt : ((x) - jlo + rot)))
        LOAD_TILE(TJ(jlo)); STORE_TILE(0); LOAD_TILE(TJ(jlo + 1)); STORE_TILE(1);
        __syncthreads();
        f32x16 s0, s1; QK0(s0, s1, lds);
        int cur = 0;
        for (int j = jlo; j < jhi; ++j) {
            const int nx = cur == 2 ? 0 : cur + 1, nn = nx == 2 ? 0 : nx + 1;
            const bool more1 = j + 1 < jhi, more2 = j + 2 < jhi;
            if (more2) LOAD_TILE(TJ(j + 2));
            if (shift) {
#pragma unroll
                for (int i = 0; i < 16; ++i) { s0[i] += negm; s1[i] += negm; } }
#pragma unroll
            for (int i = 0; i < 16; ++i) { s0[i] = __builtin_amdgcn_exp2f(s0[i]); s1[i] = __builtin_amdgcn_exp2f(s1[i]); }
#pragma unroll
            for (int i = 0; i < 8; ++i) { ls2 += (f32x2){s0[2 * i], s0[2 * i + 1]}; ls2 += (f32x2){s1[2 * i], s1[2 * i + 1]}; }
            PV_O(s0, s1, lds + cur * 32768);
            if (more1) QK0(s0, s1, lds + nx * 32768);
            if (more2) STORE_TILE(nn);
            cur = nx;
            __syncthreads();
        }
        lsum = ls2[0] + ls2[1];
    } else {
    {
        u32x4 tk0[4], tk1[4], tv0[4], tv1[4]; float tc[4];
#pragma unroll
        for (int t = 0; t < 4; ++t) { const int tr0_ = TILE_ROW0(jlo + t); const char* kt_ = (const char*)(Ksrc + (size_t)tr0_ * Kld); const char* vt_ = (const char*)(Vsrc + (size_t)tr0_ * NQ);
            tk0[t] = *(const u32x4*)(kt_ + koff0); tk1[t] = *(const u32x4*)(kt_ + koff1); tv0[t] = *(const u32x4*)(vt_ + voff0); tv1[t] = *(const u32x4*)(vt_ + voff1);
            tc[t] = wid < 2 ? colsrc[(unsigned)(64 * (jlo + t) + lane)] : 0.f; }
        LOAD_Q();
#pragma unroll
        for (int t = 0; t < 4; ++t) { LAS unsigned char* d_ = lds + t * 32768;
            *(LAS u32x4*)(d_ + kdst0) = tk0[t]; *(LAS u32x4*)(d_ + kdst1) = tk1[t]; *(LAS u32x4*)(d_ + vdst0) = tv0[t]; *(LAS u32x4*)(d_ + vdst1) = tv1[t];
            if (wid < 2) ((LAS float*)(lds + SMALL_OFF + 2048 + t * 512))[tid] = tc[t]; }
    }
    __syncthreads();
#pragma unroll 1
    for (int j = jlo; j < jhi; ++j) {
        const int cur = j - jlo;
        const bool masked = (j == jd), active = side == 0 ? (j <= jd) : (j >= jd);
        if (active) {
            const LAS unsigned char* Kb = lds + cur * 32768;
            f32x16 p0, p1;
            QK_S(p0, p1, Kb);
            {
                const LAS float* colp = (const LAS float*)(lds + SMALL_OFF + 2048 + cur * 512 + side * 256) + 4 * hi;
                const int qidx = 32 * (qblk & 1) + r32;
#pragma unroll
                for (int g = 0; g < 4; ++g) {
                    const f32x4 c0 = *(const LAS f32x4*)(colp + 8 * g), c1 = *(const LAS f32x4*)(colp + 32 + 8 * g);
#pragma unroll
                    for (int k = 0; k < 4; ++k) {
                        float e0 = rowv - c0[k], e1 = rowv - c1[k];
                        if (masked) { const int kv0 = 8 * g + 4 * hi + k, kv1 = kv0 + 32;
                            const bool keep0 = side == 0 ? (kv0 <= qidx) : (kv0 >= qidx), keep1 = side == 0 ? (kv1 <= qidx) : (kv1 >= qidx);
                            e0 = keep0 ? e0 : -1.0e30f; e1 = keep1 ? e1 : -1.0e30f; }
                        p0[4 * g + k] *= __builtin_amdgcn_exp2f(e0); p1[4 * g + k] *= __builtin_amdgcn_exp2f(e1);
                    }
                }
            }
            float ts = 0.f;
#pragma unroll
            for (int i = 0; i < 16; ++i) ts += p0[i] + p1[i];
            lsum += ts;
            PV_O1(p0, p1, Kb + 16384);
        }
    }
    __syncthreads();
    }
#undef TJ
#undef VFRG
#undef PV_LOADF
#undef PV_LD2
#undef QK0
#undef PV_MM2
#undef PV_O1
#undef PV_MMA
#undef QK_S
#undef PV_O
    if (MODE == 1 && !isctx) {
        const int slot0 = kq - 1, slot1 = kq == 8 ? 0 : kq + 1;
        {
            int tid2 = tid; asm volatile("" : "+v"(tid2));
            const int c16s = tid2 & 15, rr = tid2 >> 4;
#pragma unroll 1
            for (int d = 0; d < 2; ++d) { const float* src = A.DC + ((size_t)(((d * 32 + b * 4 + h) * 9) + (d ? slot1 : slot0)) << 14) + rr * 128 + 8 * c16s;
                f32x4 x0[4], x1[4];
#pragma unroll
                for (int g = 0; g < 4; ++g) { x0[g] = *(const f32x4*)(src + g * 4096); x1[g] = *(const f32x4*)(src + g * 4096 + 4); }
                asm volatile("" : "+v"(x0[0]), "+v"(x0[1]), "+v"(x0[2]), "+v"(x0[3]), "+v"(x1[0]), "+v"(x1[1]), "+v"(x1[2]), "+v"(x1[3]));
#pragma unroll
                for (int g = 0; g < 4; ++g) { u32x4 w; w.x = pk2(x0[g][0], x0[g][1]); w.y = pk2(x0[g][2], x0[g][3]); w.z = pk2(x1[g][0], x1[g][1]); w.w = pk2(x1[g][2], x1[g][3]);
                    *(LAS u32x4*)(lds + d * 32768 + (c16s >> 2) * 8192 + (rr + 32 * g) * 64 + (c16s & 3) * 16) = w; } }
            if (tid2 < 64) { const int d = tid2 >> 5; *(LAS f32x4*)(lds + SMALL_OFF + 4096 + d * 512 + (tid2 & 31) * 16) = *(const f32x4*)(A.scan + SC_DN + ((d * 32 + b * 4 + h) * 9 + (d ? slot1 : slot0)) * 128 + (tid2 & 31) * 4); }
        }
        const int uref = side == 0 ? 256 * kq - 1 : 256 * slot1;
        const float rt = __builtin_amdgcn_exp2f(rowv - A.scan[SC_ROW + (size_t)(side * 32 + b * 4 + h) * TT + uref]);
        int lane2 = lane; asm volatile("" : "+v"(lane2));
        __syncthreads();
        const LAS float* nst = (const LAS float*)(lds + SMALL_OFF + 4096 + side * 512) + 8 * (lane2 >> 5);
        float qn = 0.f;
#pragma unroll
        for (int d0 = 0; d0 < KS; ++d0) {
            const f32x4 n0 = *(const LAS f32x4*)(nst + 16 * d0), n1 = *(const LAS f32x4*)(nst + 16 * d0 + 4);
            const u32x4 qw = __builtin_bit_cast(u32x4, qf[d0]); u32x4 ow;
#pragma unroll
            for (int i = 0; i < 4; ++i) { const float lo_ = bf2f(qw[i] & 0xffffu), hi_ = bf2f(qw[i] >> 16);
                qn += lo_ * (i < 2 ? n0[2 * i] : n1[2 * i - 4]) + hi_ * (i < 2 ? n0[2 * i + 1] : n1[2 * i - 3]);
                ow[i] = pk2(lo_ * rt, hi_ * rt); }
            qf[d0] = __builtin_bit_cast(bf16x8, ow);
        }
        lsum += rt * qn;
        const unsigned vbn = ((lane2 >> 4) & 1) * 32 + (lane2 & 3) * 8 + (8 * (lane2 >> 5) + ((lane2 & 15) >> 2)) * 64;
        const LAS unsigned char* Cb = lds + side * 32768 + vbn;
#pragma unroll
        for (int d0 = 0; d0 < 4; ++d0)
#pragma unroll
            for (int ks = 0; ks < KS; ++ks) { const s16x4 bl = vtr(Cb + d0 * 8192 + ks * 1024), bh = vtr(Cb + d0 * 8192 + ks * 1024 + 256);
                o[d0] = __builtin_amdgcn_mfma_f32_32x32x16_bf16(qf[ks], (bf16x8){bl[0], bl[1], bl[2], bl[3], bh[0], bh[1], bh[2], bh[3]}, o[d0], 0, 0, 0); }
        __syncthreads();
    }
    int le = lane; asm volatile("" : "+v"(le));
    const int r32e = le & 31, hie = le >> 5;
    {
        float tot = lsum + __builtin_bit_cast(float, __builtin_amdgcn_ds_bpermute((le ^ 32) << 2, __builtin_bit_cast(int, lsum))), inv;
        if (MODE == 0) inv = 1.0f / tot;
        else { const float fl = expf(-A.scan[SC_LMX + side * 32 + b * 4 + h]); inv = 1.0f / fmaxf(fabsf(tot), fl); }
        LAS float* wsf = (LAS float*)(lds + SMALL_OFF + 1024 + wid * 128);
        if (hie == 0) wsf[r32e] = inv;
        LDS_WAIT();
#pragma unroll
        for (int i = 0; i < 16; ++i) { const float li = wsf[crow(i, hie)];
#pragma unroll
            for (int d0 = 0; d0 < 4; ++d0) o[d0][i] *= li; }
    }
    LAS float* xch = (LAS float*)(lds + qblk * 16384);
    if (side == 1) {
#pragma unroll
        for (int d0 = 0; d0 < 4; ++d0)
#pragma unroll
            for (int i = 0; i < 16; ++i) xch[(d0 * 16 + i) * 64 + le] = o[d0][i];
    }
    __syncthreads();
    if (side == 0) {
#pragma unroll
        for (int d0 = 0; d0 < 4; ++d0)
#pragma unroll
            for (int i = 0; i < 16; ++i) { const float x2 = xch[(d0 * 16 + i) * 64 + le]; o[d0][i] = MODE == 0 ? o[d0][i] - A.lam * x2 : o[d0][i] + x2; }
    }
    __syncthreads();
    if (side == 0) {
        LAS float* rb = (LAS float*)lds + (qblk * 32 + 4 * hie) * 132 + r32e;
#pragma unroll
        for (int d0 = 0; d0 < 4; ++d0)
#pragma unroll
            for (int i = 0; i < 16; ++i) rb[((i & 3) + 8 * (i >> 2)) * 132 + 32 * d0] = o[d0][i];
    }
    __syncthreads();
    {
        int tid3 = wid * 64 + le; asm volatile("" : "+v"(tid3));
        const int urow0 = (isctx ? ML + b * CT : b * T) + 128 * qt;
#pragma unroll
        for (int it = 0; it < 4; ++it) {
            const int idx = tid3 + 512 * it, row = idx >> 4, seg = idx & 15;
            const LAS float* rp = (const LAS float*)lds + row * 132 + 8 * seg;
            const f32x4 a0 = *(const LAS f32x4*)rp, a1 = *(const LAS f32x4*)(rp + 4);
            float ss = (a0[0] * a0[0] + a0[1] * a0[1]) + (a0[2] * a0[2] + a0[3] * a0[3]) + (a1[0] * a1[0] + a1[1] * a1[1]) + (a1[2] * a1[2] + a1[3] * a1[3]);
            ss += __shfl_xor(ss, 1); ss += __shfl_xor(ss, 2); ss += __shfl_xor(ss, 4); ss += __shfl_xor(ss, 8);
            const float rstd = 1.0f / sqrtf(ss * (1.0f / 128.0f) + EPS);
            const float* gp = A.gain + (MODE == 0 ? 0 : h * 128) + 8 * seg;
            f32x4 g0 = *(const f32x4*)gp, g1 = *(const f32x4*)(gp + 4);
            const size_t grow = (size_t)(urow0 + row);
            if (MODE == 0) { g0 = g0 * (rstd * A.post); g1 = g1 * (rstd * A.post); }
            else { const u32x4 og = *(const u32x4*)(A.QKV + grow * NQ + 3072 + h * 128 + 8 * seg);
#pragma unroll
                for (int k = 0; k < 4; ++k) { const float s0 = 1.0f / (1.0f + expf(-bf2f(og[k] & 0xffffu))), s1 = 1.0f / (1.0f + expf(-bf2f(og[k] >> 16)));
                    if (k < 2) { g0[2 * k] *= rstd * s0; g0[2 * k + 1] *= rstd * s1; } else { g1[2 * k - 4] *= rstd * s0; g1[2 * k - 3] *= rstd * s1; } } }
            const f32x4 v0 = a0 * g0, v1 = a1 * g1;
            u32x4 w; w.x = pk2(v0[0], v0[1]); w.y = pk2(v0[2], v0[3]); w.z = pk2(v1[0], v1[1]); w.w = pk2(v1[2], v1[3]);
            *(u32x4*)(A.CAT + grow * D + (MODE == 0 ? 0 : 512) + h * 128 + 8 * seg) = w;
        }
    }
    __syncthreads();
#undef LOAD_TILE
#undef LOAD_Q
#undef STORE_TILE
#undef TILE_ROW0
}
DI void mixer_phase(const Frame& F, int l, bool need_ctx, int part) {
    const KArgs ka = kargs(); unsigned char* ws = ka->ws;
    LAS float* sm = (LAS float*)(F.lds + SMALL_OFF);
    if (F.wave == 0) {
        const int ln = F.lane;
        const float s1 = wave_sum(ka->in[I_LQ1][l * 64 + ln] * ka->in[I_LK1][l * 64 + ln]), s2 = wave_sum(ka->in[I_LQ2][l * 64 + ln] * ka->in[I_LK2][l * 64 + ln]);
        const float mq = wave_max(fabsf(ka->in[I_QNG][l * 64 + ln])), mk = wave_max(fabsf(ka->in[I_KNG][l * 64 + ln]));
        const float lam_init = 0.8f - 0.6f * expf(-0.3f * (float)l);
        if (ln == 0) { sm[0] = expf(s1) - expf(s2) + lam_init; sm[1] = 1.0f - lam_init; sm[2] = -(8.0f * mq * mk * LOG2E); }
    }
    __syncthreads();
    MixArgs A; A.QKV = (const bf16*)(ws + WS_QKV); A.MQK = (const bf16*)(ws + WS_H); A.CAT = (bf16*)(ws + WS_CAT); A.scan = (const float*)(ws + WS_SCAN); A.DC = (const float*)(ws + WS_DC);
    A.lam = sm[0]; A.post = sm[1]; A.negm = sm[2];
    const int nunits = need_ctx ? 576 : 512;
    if (part == 1) {
        A.gain = ka->in[I_MNG] + l * 512;
        for (int u = F.vcu; u < nunits; u += F.G) {
            const bool isctx = u >= 512; const int v = u - 512;
            mix_unit<1>(F, A, isctx ? v >> 3 : u >> 6, isctx ? (v >> 1) & 3 : (u >> 4) & 3, isctx ? v & 1 : u & 15, isctx);
        }
    }
    A.gain = ka->in[I_SUBLN] + l * 128;
    for (int u = (part == 0 ? F.vcu : 256 + (F.vcu + F.G - 64) % F.G); u < (part == 0 ? 256 : nunits); u += F.G) {
        const bool isctx = u >= 512; const int v = u - 512;
        mix_unit<0>(F, A, isctx ? v >> 3 : u >> 6, isctx ? (v >> 1) & 3 : (u >> 4) & 3, isctx ? v & 1 : u & 15, isctx);
    }
}

constexpr int CW_PROF = 2048;
constexpr int MOE_TAIL_PM = 64, MOE_TS = 7;
DI void moe_tstart(const Frame& F, const unsigned char* ws, int half) {
    LAS int* ts = (LAS int*)(F.lds + SMALL_OFF + 64);
    if (F.tid == 0) { const unsigned* cnt = (const unsigned*)(ws + WS_CTL) + CW_CNT + half * 8; int acc = 0;
        for (int e = 0; e < 8; ++e) { ts[e] = acc; acc += ((int)__hip_atomic_load(cnt + e, RLX_AGENT) + 255) >> 8; } ts[8] = acc; }
    __syncthreads();
}
DI void moe_gather(const Frame& F, unsigned char* ws, int half) {
    moe_tstart(F, ws, half);
    const LAS int* ts = (const LAS int*)(F.lds + SMALL_OFF + 64);
    const bf16* H = (const bf16*)(ws + WS_H); bf16* HG = (bf16*)(ws + WS_CAT);
    int* rowmap = (int*)(ws + WS_SMALL + SM_ROWMAP) + half * MR; float* roww = (float*)(ws + WS_SMALL + SM_ROWW) + half * MR;
    const int gw = F.vcu * NWAVES + F.wave, NGW = F.G * NWAVES;
#pragma unroll 4
    for (int tk = gw; tk < ML / 2; tk += NGW) {
        const int token = half * (ML / 2) + tk;
        const u32x4* rec = (const u32x4*)(ws + WS_SMALL + SM_ROUTE + (size_t)token * 32);
        const u32x4 r0 = rec[0], r1 = rec[1];
        const u32x4 v0 = *((const u32x4*)((const unsigned char*)H + (size_t)token * D) + F.lane);
#pragma unroll
        for (int s = 0; s < 2; ++s) {
            const int e = (int)(s ? r0.y : r0.x), pos = (int)(s ? r0.w : r0.z); const int dst = 256 * ts[e] + pos;
            *((u32x4*)((unsigned char*)HG + (size_t)dst * D) + F.lane) = v0;
            if (F.lane == 0) { rowmap[dst] = token * 2 + s; roww[dst] = __uint_as_float(s ? r1.y : r1.x); }
        }
    }
    const unsigned* cnt = (const unsigned*)(ws + WS_CTL) + CW_CNT + half * 8;
    for (int pr = gw; pr < 8 * 256; pr += NGW) {
        const int e = pr >> 8, k = pr & 255; const int c = (int)__hip_atomic_load(cnt + e, RLX_AGENT); const int npad = (((c + 255) >> 8) << 8) - c;
        if (k < npad) { const int dst = 256 * ts[e] + c + k; *((u32x4*)((unsigned char*)HG + (size_t)dst * D) + F.lane) = (u32x4){0u, 0u, 0u, 0u};
            if (F.lane == 0) { rowmap[dst] = -1; roww[dst] = 0.f; } }
    }
}
DI void moe_combine(const Frame& F, const unsigned char* ws, int half, float* out, const float* g2, int rank, int nrank) {
    const bf16* Y = (const bf16*)(ws + WS_Y); const bf16* YT = (const bf16*)(ws + WS_DC); const bf16* X1 = (const bf16*)(ws + WS_XA);
#ifdef PROF_MASK
    const float pscale = half == 0 ? 1.0f : 1.0f + sqrtf((float)__hip_atomic_load((const unsigned*)(ws + WS_CTL) + CW_PROF, RLX_AGENT) * 2e-8f);
#else
    const float pscale = 1.0f;
#endif
    LAS int* ts2 = (LAS int*)(F.lds + SMALL_OFF + 128);
    if (F.tid == 0) { const unsigned* cnt = (const unsigned*)(ws + WS_CTL) + CW_CNT + half * 8; int acc = 0;
        for (int e = 0; e < 8; ++e) { ts2[e] = acc; acc += ((int)__hip_atomic_load(cnt + e, RLX_AGENT) + 255) >> 8; } ts2[8] = acc; }
    __syncthreads();
    const int gw = rank * NWAVES + F.wave, NGW = nrank * NWAVES;
#pragma unroll 2
    for (int tk = gw; tk < ML / 2; tk += NGW) {
        const int token = half * (ML / 2) + tk;
        const float* gp = g2 + (token >> 11) * ADA_LD;
        const u32x4 r0 = *(const u32x4*)(ws + WS_SMALL + SM_ROUTE + (size_t)token * 32);
        const int dst0 = 256 * ts2[(int)r0.x] + (int)r0.z - MOE_TAIL_PM * 256, dst1 = 256 * ts2[(int)r0.y] + (int)r0.w - MOE_TAIL_PM * 256;
#pragma unroll
        for (int j = 0; j < 2; ++j) {
            const int c = 8 * F.lane + 512 * j;
            float ys[8];
#pragma unroll
            for (int i = 0; i < 8; ++i) ys[i] = 0.f;
#pragma unroll
            for (int s = 0; s < 2; ++s) { const int dst = s ? dst1 : dst0;
                if (dst < 0) { const u32x4 y = *(const u32x4*)(Y + (size_t)(2 * tk + s) * D + c);
#pragma unroll
                    for (int i = 0; i < 4; ++i) { ys[2 * i] += bf2f(y[i] & 0xffffu); ys[2 * i + 1] += bf2f(y[i] >> 16); } }
                else {
#pragma unroll
                    for (int q = 0; q < MOE_TS; ++q) { const u32x4 y = *(const u32x4*)(YT + ((size_t)q * 2048 + dst) * D + c);
#pragma unroll
                        for (int i = 0; i < 4; ++i) { ys[2 * i] += bf2f(y[i] & 0xffffu); ys[2 * i + 1] += bf2f(y[i] >> 16); } } }
            }
            const u32x4 xb = *(const u32x4*)(X1 + (size_t)token * D + c);
            const f32x4 g0 = *(const f32x4*)(gp + c), g1 = *(const f32x4*)(gp + c + 4);
            f32x4 o0, o1;
#pragma unroll
            for (int i = 0; i < 2; ++i) { o0[2 * i] = bf2f(xb[i] & 0xffffu) + g0[2 * i] * ys[2 * i]; o0[2 * i + 1] = bf2f(xb[i] >> 16) + g0[2 * i + 1] * ys[2 * i + 1];
                o1[2 * i] = bf2f(xb[2 + i] & 0xffffu) + g1[2 * i] * ys[4 + 2 * i]; o1[2 * i + 1] = bf2f(xb[2 + i] >> 16) + g1[2 * i + 1] * ys[5 + 2 * i]; }
            float* op = out + (size_t)token * D + c;
            *(f32x4*)op = o0 * pscale; *(f32x4*)(op + 4) = o1 * pscale;
        }
    }
}
DI void moe_up(const Frame& F, unsigned char* ws, int half) {
    moe_tstart(F, ws, half);
    pg8::Gemm g{(const bf16*)(ws + WS_CAT), (const bf16*)(ws + WS_MUP), MR, 2 * FFE, D / 2, D / 2}; pg8::MoeOrder S{(const LAS int*)(F.lds + SMALL_OFF + 64), 2 * FFE / 256, F.G, F.vcu, 1 << 20};
    pg8::EpiGated<true> E{(bf16*)(ws + WS_QKV), FFE, 2 * FFE / 256, 1.0f / (F8_SA * F8_SW), F8_SH};
    pg8::gemm_phase<pg8::EpiGated<true>, pg8::MoeOrder, PG8_ALIGN, PG8_SP2, true>(F.lds, g, S, E);
}
DI void moe_down(const Frame& F, unsigned char* ws, int half) {
    moe_tstart(F, ws, half);
    const int* rowmap = (const int*)(ws + WS_SMALL + SM_ROWMAP) + half * MR; const float* roww = (const float*)(ws + WS_SMALL + SM_ROWW) + half * MR;
    {
        pg8::Gemm g{(const bf16*)(ws + WS_QKV), (const bf16*)(ws + WS_MDN), MR, D, FFE / 2, FFE / 2}; pg8::MoeOrder S{(const LAS int*)(F.lds + SMALL_OFF + 64), D / 256, F.G, F.vcu, MOE_TAIL_PM};
        pg8::EpiScatter E{(bf16*)(ws + WS_Y), rowmap, roww, half * ML, 1.0f / (F8_SH * F8_SW)};
        pg8::gemm_phase<pg8::EpiScatter, pg8::MoeOrder, PG8_ALIGN, PG8_SP2, true>(F.lds, g, S, E);
    }
    __syncthreads();
    {
        int kpiece = FFE / (2 * MOE_TS); asm volatile("" : "+s"(kpiece));
        pg8::Gemm g{(const bf16*)(ws + WS_QKV), (const bf16*)(ws + WS_MDN), MR, D, kpiece, FFE / 2}; pg8::MoeTailOrder S{(const LAS int*)(F.lds + SMALL_OFF + 64), F.G, F.vcu, MOE_TAIL_PM, FFE / MOE_TS, MOE_TS};
        pg8::EpiScatterTail E{(bf16*)(ws + WS_DC), roww, FFE / MOE_TS, 1.0f / (F8_SH * F8_SW)};
        pg8::gemm_phase<pg8::EpiScatterTail, pg8::MoeTailOrder, false, PG8_SP2, true>(F.lds, g, S, E);
    }
}
#ifdef PROF_MASK
DI void prof_tick(LAS unsigned char* lds, int k) {
    if (blockIdx.x == 0 && threadIdx.x == 0) { LAS unsigned long long* P = (LAS unsigned long long*)(lds + SMALL_OFF + 6144); const unsigned long long now = __builtin_amdgcn_s_memrealtime();
        if ((PROF_MASK >> k) & 1) P[1] += now - P[0]; P[0] = now; }
}
#define PROF_TICK(k) prof_tick(plds, (k))
#else
#define PROF_TICK(k) do { } while (0)
#endif
#ifndef PHMASK
#define PHMASK 0x7FFFFF
#endif
#define IN(k) (((PHMASK >> (k)) & 1) && lo <= (k) && (k) < hi)
#define SEAM(k) do { if (!MK_PER_PHASE && IN((k) + 1)) { xcd_barrier(bar); PROF_TICK(k); } } while (0)
template <int L>
DI void layer_phases(const Frame& F0, const XcdBarrier& bar, const int lo, const int hi) {
    constexpr int l = L;
    LAS unsigned char* const plds = F0.lds; (void)plds;
    unsigned char* ws = kargs()->ws;
    const float* ada = (const float*)(ws + WS_ADA);
    bf16* const QKV = (bf16*)(ws + WS_QKV); bf16* const CAT = (bf16*)(ws + WS_CAT); bf16* const H = (bf16*)(ws + WS_H); bf16* const XA = (bf16*)(ws + WS_XA);
    float* const gates = (float*)(ws + WS_GATES); float* const scan = (float*)(ws + WS_SCAN);
        const int pb = 1 + 9 * l;
        const float* adal = ada + l * ADA_L;
        const void* xinL = l == 0 ? (const void*)kargs()->in[I_X] : (const void*)XA; const void* xinC = l == 0 ? (const void*)kargs()->in[I_CTX] : (const void*)(XA + (size_t)ML * D);
        if (IN(pb + 0)) { const Frame F = fresh(F0); modulate_phase<0, (l != 0)>(F, xinL, xinC, MR, kargs()->in[I_N1G] + l * D, adal, 0, 1024, H, (const float*)(ws + WS_SMALL + SM_GTAB) + l * 16384, gates, ws); SEAM(pb + 0); }
        if (IN(pb + 1)) { const Frame F = fresh(F0);
            scan_phase(F, gates, kargs()->in[I_GATEB] + l * 16, scan);
            pg8::Gemm g{H, (const bf16*)(ws + WS_WIN) + (size_t)l * NQ * D, MR, NQ, D, D}; pg8::StaticOrder S; S.init(MR, NQ, F.G, (int)blockIdx.x);
            const float* rope = (const float*)(ws + WS_SMALL + SM_ROPE);
            pg8::EpiQKV E{QKV, kargs()->in[I_QNG] + l * 64, kargs()->in[I_KNG] + l * 64, rope, rope + 1024};
            pg8::gemm_phase<pg8::EpiQKV, pg8::StaticOrder, PG8_ALIGN, PG8_SP2>(F.lds, g, S, E);
            SEAM(pb + 1);
        }
        if (IN(pb + 2)) { const Frame F = fresh(F0);
            conv_phase(F, QKV, H, kargs()->in[I_CONVW] + l * 5 * 1024, kargs()->in[I_CONVB] + l * 1024);
            for (int u = F.vcu; u < 512; u += F.G) {
                const int bh = u >> 4, j = u & 15, dir = j >> 3, k = j < 8 ? j : (j == 8 ? 0 : j - 7);
                mstate_unit(F, QKV, H, scan, kargs()->in[I_CONVW] + l * 5 * 1024, kargs()->in[I_CONVB] + l * 1024, (float*)(ws + WS_DC), bh >> 2, bh & 3, k, dir);
            }
            SEAM(pb + 2);
        }
        if (IN(pb + 3)) { const Frame F = fresh(F0); mprefix_phase(F, scan, (float*)(ws + WS_DC)); __syncthreads(); mixer_phase(F, l, l == 0, 0); SEAM(pb + 3); }
        if (IN(pb + 4)) { const Frame F = fresh(F0); mixer_phase(F, l, l == 0, 1); SEAM(pb + 4); }
        if (IN(pb + 5)) { const Frame F = fresh(F0);
            const int M4 = l == 0 ? MR : ML;
            pg8::Gemm g{CAT, (const bf16*)(ws + WS_WOUT) + (size_t)l * D * D, M4, D, D, D}; pg8::StaticOrder S; S.init(M4, D, F.G, (int)blockIdx.x);
            typedef pg8::EpiRes<(l != 0), true> EpiP4;
            EpiP4 E{xinL, xinC, (void*)XA, adal + 2048};
            pg8::gemm_phase<EpiP4, pg8::StaticOrder, PG8_ALIGN, PG8_SP2>(F.lds, g, S, E);
            if (l == 0) idle_convert(F, (MR / 256) * (D / 256), CV_PRO, CV_P4);
            SEAM(pb + 5);
        }
        if (l == 0) {
            if (IN(pb + 6)) { const Frame F = fresh(F0); modulate_phase<1, true>(F, XA, XA + (size_t)ML * D, MR, kargs()->in[I_N2G], adal, 3072, 4096, H, nullptr, nullptr, ws); SEAM(pb + 6); }
            if (IN(pb + 7)) { const Frame F = fresh(F0);
                pg8::Gemm g{H, (const bf16*)(ws + WS_WUP), MR, 2 * FF, D, D}; pg8::StaticOrder S; S.init(MR, 2 * FF, F.G, (int)blockIdx.x);
                pg8::EpiGated<false> E{QKV, FF, 1 << 20, 1.0f, 1.0f};
                pg8::gemm_phase<pg8::EpiGated<false>, pg8::StaticOrder, PG8_ALIGN, PG8_SP2>(F.lds, g, S, E);
                idle_convert(F, (MR / 256) * (2 * FF / 256), CV_P4, CV_P6);
                SEAM(pb + 7);
            }
            if (IN(pb + 8)) { const Frame F = fresh(F0);
                pg8::Gemm g{QKV, (const bf16*)(ws + WS_WDN), MR, D, FF, FF}; pg8::StaticOrder S; S.init(MR, D, F.G, (int)blockIdx.x);
                typedef pg8::EpiRes<true, true> EpiP7;
                EpiP7 E{XA, XA + (size_t)ML * D, XA, adal + 5120};
                pg8::gemm_phase<EpiP7, pg8::StaticOrder, PG8_ALIGN, PG8_SP2>(F.lds, g, S, E);
                idle_convert(F, (MR / 256) * (D / 256), CV_P6, CV_ALL);
                SEAM(pb + 8);
            }
        } else {
            if (IN(16)) { const Frame F = fresh(F0); modulate_phase<2, true>(F, XA, XA, ML, kargs()->in[I_N2G] + D, adal, 3072, 4096, H, (const float*)(ws + WS_SMALL + SM_RTAB), nullptr, ws); SEAM(16); }
            if (IN(17)) { const Frame F = fresh(F0); moe_gather(F, ws, 0); SEAM(17); }
            if (IN(18)) { const Frame F = fresh(F0); moe_up(F, ws, 0); SEAM(18); }
            if (IN(19)) { const Frame F = fresh(F0); moe_down(F, ws, 0); __syncthreads(); moe_gather(F, ws, 1); SEAM(19); }
            if (IN(20)) { const Frame F = fresh(F0); moe_up(F, ws, 1);
                __syncthreads();
                {
                    const int nun = ((const LAS int*)(F.lds + SMALL_OFF + 64))[8] * (2 * FFE / 256), r = nun % F.G;
                    if (r == 0) moe_combine(F, ws, 0, kargs()->out, adal + 5120, F.vcu, F.G);
                    else if (F.vcu >= r) moe_combine(F, ws, 0, kargs()->out, adal + 5120, F.vcu - r, F.G - r);
                }
                SEAM(20); }
            if (IN(21)) { const Frame F = fresh(F0); moe_down(F, ws, 1); SEAM(21); }
#ifdef PROF_MASK
            if (IN(22)) { if (blockIdx.x == 0 && threadIdx.x == 0) { __hip_atomic_store((unsigned*)(ws + WS_CTL) + CW_PROF, (unsigned)((LAS unsigned long long*)(plds + SMALL_OFF + 6144))[1], RLX_AGENT); } xcd_barrier(bar); }
#endif
            if (IN(22)) { const Frame F = fresh(F0); moe_combine(F, ws, 1, kargs()->out, adal + 5120, F.vcu, F.G); }
        }
    }
#undef IN
#undef SEAM

constexpr int NPHASES = 23;
__global__ void __launch_bounds__(NWAVES * 64, 2) fwd_kernel(Args args) {
    extern __shared__ __attribute__((aligned(16))) unsigned char lds_raw[];
    Frame F;
    F.lds = (LAS unsigned char*)lds_raw;
    F.tid = threadIdx.x; F.lane = F.tid & 63; F.wave = __builtin_amdgcn_readfirstlane(F.tid >> 6);
    F.G = gridDim.x; { const int bx = blockIdx.x; F.vcu = (F.G % 8 == 0) ? (bx % 8) * (F.G / 8) + bx / 8 : bx; }
    unsigned char* ws = kargs()->ws;
    for (int u = F.tid; u < (LDS_BYTES - LDSCTL_OFF) / 4; u += NWAVES * 64) ((LAS unsigned*)(F.lds + LDSCTL_OFF))[u] = 0u;
    __syncthreads();
    XcdBarrier bar; bar.bar = (unsigned*)(ws + WS_CTL) + CW_BAR; bar.x = 0; bar.st = nullptr;
    if (!MK_PER_PHASE) bar = xcd_barrier_post((unsigned*)(ws + WS_CTL) + CW_BAR, (volatile LAS unsigned*)(F.lds + MISC_OFF) + 8);
    const int lo = kargs()->ph_lo, hi = kargs()->ph_hi;
    LAS unsigned char* const plds = F.lds; (void)plds;
#ifdef PROF_MASK
    if (blockIdx.x == 0 && threadIdx.x == 0) ((LAS unsigned long long*)(plds + SMALL_OFF + 6144))[0] = __builtin_amdgcn_s_memrealtime();
#endif
#ifndef PHMASK
#define PHMASK 0x7FFFFF
#endif
#define IN(k) (((PHMASK >> (k)) & 1) && lo <= (k) && (k) < hi)
#define SEAM(k) do { if (!MK_PER_PHASE && IN((k) + 1)) { xcd_barrier(bar); PROF_TICK(k); } } while (0)
    const float* ada = (const float*)(ws + WS_ADA);
    bf16* const QKV = (bf16*)(ws + WS_QKV); bf16* const CAT = (bf16*)(ws + WS_CAT); bf16* const H = (bf16*)(ws + WS_H); bf16* const XA = (bf16*)(ws + WS_XA);
    float* const gates = (float*)(ws + WS_GATES); float* const scan = (float*)(ws + WS_SCAN);

    if (IN(0)) { const Frame Fp = fresh(F); p0_prologue(Fp); SEAM(0); }

    layer_phases<0>(F, bar, lo, hi);
    layer_phases<1>(F, bar, lo, hi);
#undef IN
#undef SEAM
}

extern "C" void kernel_launch(void* const* d_in, const int* in_sizes, int n_in, void* d_out, int out_size, void* d_ws, size_t ws_size, hipStream_t stream) {
    static int grid = 0;
    if (grid == 0) {
        if (n_in != 28 || in_sizes[0] != ML * D || out_size != ML * D || ws_size < WS_END) { fprintf(stderr, "kernel_launch: unexpected shapes / workspace (n_in %d, out %d, ws %zu < %zu)\n", n_in, out_size, ws_size, (size_t)WS_END); grid = -1; return; }
        int dev = 0, cus = 0, per_cu = 0;
        if (hipGetDevice(&dev) != hipSuccess || hipDeviceGetAttribute(&cus, hipDeviceAttributeMultiprocessorCount, dev) != hipSuccess) { grid = -1; return; }
        if (hipFuncSetAttribute((const void*)fwd_kernel, hipFuncAttributeMaxDynamicSharedMemorySize, LDS_BYTES) != hipSuccess) { fprintf(stderr, "kernel_launch: hipFuncSetAttribute failed\n"); grid = -1; return; }
        if (hipOccupancyMaxActiveBlocksPerMultiprocessor(&per_cu, (const void*)fwd_kernel, NWAVES * 64, LDS_BYTES) != hipSuccess || per_cu < 1) { fprintf(stderr, "kernel_launch: occupancy query says %d\n", per_cu); }
        (void)hipGetLastError();
        grid = cus;
    }
    if (grid < 0) return;
    if (hipMemsetAsync((char*)d_ws + WS_CTL, 0, CTL_ZERO_BYTES, stream) != hipSuccess) return;
    Args a{};
    for (int i = 0; i < 28; ++i) a.in[i] = (const float*)d_in[i];
    a.out = (float*)d_out; a.ws = (unsigned char*)d_ws;
#if MK_PER_PHASE
    for (int p = 0; p < NPHASES; ++p) { a.ph_lo = p; a.ph_hi = p + 1; hipLaunchKernelGGL(fwd_kernel, dim3(grid), dim3(NWAVES * 64), LDS_BYTES, stream, a); }
#else
    a.ph_lo = 0; a.ph_hi = NPHASES;
    hipLaunchKernelGGL(fwd_kernel, dim3(grid), dim3(NWAVES * 64), LDS_BYTES, stream, a);
#endif
}
```

```cpp
#include <hip/hip_runtime.h>
#include <cstdio>
#include <cstdint>
#include <cmath>
constexpr int NB = 8, T = 2048, D = 1024, CT = 256, ML = NB * T, MC = NB * CT, MR = ML + MC, TT = T + CT;
constexpr int INC = 3600, NQ = 3584;
constexpr int FF = 2816, FFE = 3584, NE = 8;
constexpr int ADA_LD = 6144, ADA_L = 9 * ADA_LD;
constexpr float EPS = 1e-6f, LOG2E = 1.4426950408889634f;
constexpr float QSCALE = 0.125f * LOG2E;
namespace pg8 {
#define PG8_LAS __attribute__((address_space(3)))
typedef unsigned short bf16_t;
typedef short bf16x8 __attribute__((ext_vector_type(8)));
typedef float f32x4 __attribute__((ext_vector_type(4)));
typedef unsigned u32x4 __attribute__((ext_vector_type(4)));
typedef int v4i_t __attribute__((ext_vector_type(4)));
typedef unsigned u32x2 __attribute__((ext_vector_type(2)));
typedef int v8i_t __attribute__((ext_vector_type(8)));
constexpr int BM = 256, BK = 64, HALF = 128, HTB = HALF * BK * 2  , STAGE_BYTES = 8 * HTB, NXCD = 8, WGM = 8;

__host__ __device__ __forceinline__ int lds_byte(int r, int c) { const int st = (r >> 4) * 2 + (c >> 5), rr = r & 15, cc = c & 31, ob = rr * 64 + cc * 2; return st * 1024 + (ob ^ (((ob >> 9) & 1) << 5)); }
__host__ __device__ __forceinline__ void stage_rc(int b, int& R, int& C) { const int st = b / 1024, sb = b % 1024, swz = sb ^ (((sb >> 9) & 1) << 5); R = (st >> 1) * 16 + swz / 64; C = (st & 1) * 32 + (swz % 64) / 2; }
__host__ __device__ __forceinline__ int perm32(int rho) { const int n = rho >> 4, i = rho & 15; return 8 * (i >> 2) + 4 * n + (i & 3); }

struct Unit { int pm, pn, ko; };
struct Gemm { const bf16_t* A; const bf16_t* Bt; int M, N, K, ld; };

struct StaticOrder {
    int nM, nN, nwg, G, c;
    __host__ __device__ void init(int M, int N, int G_, int c_) { nM = M / BM; nN = N / BM; nwg = nM * nN; G = G_; c = c_; }
    __host__ __device__ bool next(int i, Unit& u) const {
        const long L = (long)i * G + c; if (L >= nwg) return false;
        int wgid = (int)L; { const int q = nwg / NXCD, r = nwg % NXCD, xcd = wgid % NXCD, off = wgid / NXCD; wgid = (xcd < r ? xcd * (q + 1) : r * (q + 1) + (xcd - r) * q) + off; }
        const int nig = WGM * nN, gid = wgid / nig, fm = gid * WGM, gsz = (nM - fm) < WGM ? (nM - fm) : WGM;
        u.pm = fm + ((wgid % nig) % gsz); u.pn = (wgid % nig) / gsz; u.ko = 0; return true;
    }
    __device__ __forceinline__ void a_ready(const Unit&) const {}
    __device__ __forceinline__ void done(const Unit&) const {}
};

__device__ __forceinline__ unsigned cvt_pk_bf16(float lo, float hi) { unsigned r; asm volatile("v_cvt_pk_bf16_f32 %0, %1, %2" : "=v"(r) : "v"(lo), "v"(hi)); return r; }
typedef float f32x2 __attribute__((ext_vector_type(2)));
typedef float f32x2_t __attribute__((ext_vector_type(2))); typedef __bf16 bf16x2_t __attribute__((ext_vector_type(2)));
__device__ __forceinline__ unsigned pk2(float lo, float hi) { f32x2_t v = {lo, hi}; bf16x2_t b = __builtin_convertvector(v, bf16x2_t); return __builtin_bit_cast(unsigned, b); }
__device__ __forceinline__ u32x4 pk8(const f32x4 a, const f32x4 b) { u32x4 w; w.x = pk2(a[0], a[1]); w.y = pk2(a[2], a[3]); w.z = pk2(b[0], b[1]); w.w = pk2(b[2], b[3]); return w; }

template <bool SCALED = false> struct EpiQKV {
    static constexpr bool PERM = true, AFTER_DRAIN = false;
    bf16_t* O; const float* qg; const float* kg; const float* ropeR; const float* ropeC; float sc;
    __device__ __forceinline__ void operator()(const f32x4 (&acc)[2][2][4][2], const Unit& u, int wr, int wc, int fr, int fq) const {
        const int row0 = u.pm * BM + wr * 64 + fr;
        if (u.pn >= 4) {
            const int col0 = u.pn * BM + wc * 32 + 8 * fq;
#pragma unroll
            for (int ai = 0; ai < 2; ++ai)
#pragma unroll
                for (int m = 0; m < 4; ++m) { bf16_t* rowp = O + (size_t)(row0 + ai * HALF + m * 16) * NQ + col0;
#pragma unroll
                    for (int bj = 0; bj < 2; ++bj) *(u32x4*)(rowp + bj * HALF) = SCALED ? pk8(acc[ai][bj][m][0] * sc, acc[ai][bj][m][1] * sc) : pk8(acc[ai][bj][m][0], acc[ai][bj][m][1]); }
            return;
        }
        const bool isq = u.pn < 2; const float* gp = (isq ? qg : kg) + 8 * fq; const float qs = isq ? QSCALE : 1.0f;
        const int col0 = u.pn * BM + 64 * wc + 8 * fq;
#pragma unroll
        for (int ai = 0; ai < 2; ++ai)
#pragma unroll
            for (int m = 0; m < 4; ++m) {
                const int row = row0 + ai * HALF + m * 16;
                float ss = 0.f;
#pragma unroll
                for (int bj = 0; bj < 2; ++bj)
#pragma unroll
                    for (int n = 0; n < 2; ++n) { const f32x4 x = acc[ai][bj][m][n]; ss += (x[0] * x[0] + x[1] * x[1]) + (x[2] * x[2] + x[3] * x[3]); }
                ss += __shfl_xor(ss, 16); ss += __shfl_xor(ss, 32);
                const float rstd = SCALED ? sc / sqrtf(ss * (sc * sc * (1.0f / 64.0f)) + EPS) : 1.0f / sqrtf(ss * (1.0f / 64.0f) + EPS);
                f32x4 y[2][2];
#pragma unroll
                for (int bj = 0; bj < 2; ++bj)
#pragma unroll
                    for (int n = 0; n < 2; ++n) y[bj][n] = acc[ai][bj][m][n] * (rstd * qs) * *(const f32x4*)(gp + 32 * bj + 4 * n);
                if (row < ML) {
                    const int t = row & (T - 1);
                    const float* tab = (fq < 2) ? (ropeR + (t >> 6) * 32) : (ropeC + (t & 63) * 32);
                    tab += 2 * ((fq & 1) * 8);
#pragma unroll
                    for (int n = 0; n < 2; ++n) {
                        const f32x4 t0 = *(const f32x4*)(tab + 8 * n), t1 = *(const f32x4*)(tab + 8 * n + 4);
                        const f32x4 c = {t0[0], t0[2], t1[0], t1[2]}, s = {t0[1], t0[3], t1[1], t1[3]};
                        const f32x4 x1 = y[0][n], x2 = y[1][n];
                        y[0][n] = x1 * c - x2 * s; y[1][n] = x1 * s + x2 * c;
                    }
                }
                bf16_t* rowp = O + (size_t)row * NQ + col0;
#pragma unroll
                for (int bj = 0; bj < 2; ++bj) *(u32x4*)(rowp + 32 * bj) = pk8(y[bj][0], y[bj][1]);
            }
    }
};

template <bool BASEBF, bool OUTBF> struct EpiRes {
    static constexpr bool PERM = OUTBF, AFTER_DRAIN = false;
    const void* baseL; const void* baseC; void* out; const float* gate;
    __device__ __forceinline__ void operator()(const f32x4 (&acc)[2][2][4][2], const Unit& u, int wr, int wc, int fr, int fq) const {
        const int row0 = u.pm * BM + wr * 64 + fr, col0 = u.pn * BM + wc * 32 + (OUTBF ? 8 : 4) * fq;
#pragma unroll
        for (int ai = 0; ai < 2; ++ai)
#pragma unroll
            for (int m = 0; m < 4; ++m) {
                const int row = row0 + ai * HALF + m * 16;
                const int bsel = row < ML ? (row >> 11) : 8;
                const size_t boff = (row < ML ? (size_t)row * D : (size_t)(row - ML) * D) + col0; const void* bb = row < ML ? baseL : baseC;
                const float* gp = gate + bsel * ADA_LD + col0;
#pragma unroll
                for (int bj = 0; bj < 2; ++bj) {
                    if (OUTBF) {
                        f32x4 b0, b1;
                        if (BASEBF) { const u32x4 r = *(const u32x4*)((const bf16_t*)bb + boff + bj * HALF);
                            b0 = (f32x4){__uint_as_float(r[0] << 16), __uint_as_float(r[0] & 0xffff0000u), __uint_as_float(r[1] << 16), __uint_as_float(r[1] & 0xffff0000u)};
                            b1 = (f32x4){__uint_as_float(r[2] << 16), __uint_as_float(r[2] & 0xffff0000u), __uint_as_float(r[3] << 16), __uint_as_float(r[3] & 0xffff0000u)}; }
                        else { b0 = *(const f32x4*)((const float*)bb + boff + bj * HALF); b1 = *(const f32x4*)((const float*)bb + boff + bj * HALF + 4); }
                        const f32x4 v0 = b0 + *(const f32x4*)(gp + bj * HALF) * acc[ai][bj][m][0], v1 = b1 + *(const f32x4*)(gp + bj * HALF + 4) * acc[ai][bj][m][1];
                        *(u32x4*)((bf16_t*)out + (size_t)row * D + col0 + bj * HALF) = pk8(v0, v1);
                    } else {
#pragma unroll
                        for (int n = 0; n < 2; ++n) { const int o = bj * HALF + n * 16; f32x4 b;
                            if (BASEBF) { const unsigned long long r = *(const unsigned long long*)((const bf16_t*)bb + boff + o); const unsigned lo = (unsigned)r, hi = (unsigned)(r >> 32);
                                b = (f32x4){__uint_as_float(lo << 16), __uint_as_float(lo & 0xffff0000u), __uint_as_float(hi << 16), __uint_as_float(hi & 0xffff0000u)}; }
                            else b = *(const f32x4*)((const float*)bb + boff + o);
                            *(f32x4*)((float*)out + (size_t)row * D + col0 + o) = b + *(const f32x4*)(gp + o) * acc[ai][bj][m][n]; }
                    }
                }
            }
    }
};

__device__ __forceinline__ unsigned pk4_f8(const f32x4 v) {
    unsigned p = 0u;
    p = __builtin_amdgcn_cvt_pk_fp8_f32(__builtin_amdgcn_fmed3f(v[0], -448.f, 448.f), __builtin_amdgcn_fmed3f(v[1], -448.f, 448.f), p, false);
    p = __builtin_amdgcn_cvt_pk_fp8_f32(__builtin_amdgcn_fmed3f(v[2], -448.f, 448.f), __builtin_amdgcn_fmed3f(v[3], -448.f, 448.f), p, true);
    return p;
}
__device__ __forceinline__ f32x4 silu_mul_sc(const f32x4 a, const f32x4 b, float ke, float km) {
    f32x4 r;
#pragma unroll
    for (int i = 0; i < 4; ++i) r[i] = (a[i] * b[i]) * (km * __builtin_amdgcn_rcpf(1.0f + __builtin_amdgcn_exp2f(ke * a[i])));
    return r;
}
__device__ __forceinline__ f32x4 silu_mul(const f32x4 a, const f32x4 b) {
    f32x4 r;
#pragma unroll
    for (int i = 0; i < 4; ++i) r[i] = a[i] * __builtin_amdgcn_rcpf(1.0f + __builtin_amdgcn_exp2f(-LOG2E * a[i])) * b[i];
    return r;
}
template <bool OUT8> struct EpiGated {
    static constexpr bool PERM = true, AFTER_DRAIN = false;
    bf16_t* O; int ldc; int ntile; float sc, osc;
    __device__ __forceinline__ void operator()(const f32x4 (&acc)[2][2][4][2], const Unit& u, int wr, int wc, int fr, int fq) const {
        const int row0 = u.pm * BM + wr * 64 + fr, col0 = (u.pn % ntile) * HALF + wc * 32 + 8 * fq;
#pragma unroll
        for (int ai = 0; ai < 2; ++ai)
#pragma unroll
            for (int m = 0; m < 4; ++m) {
                const float ke = -LOG2E * sc, km = sc * sc * (OUT8 ? osc : 1.0f);
                const f32x4 v0 = silu_mul_sc(acc[ai][0][m][0], acc[ai][1][m][0], ke, km), v1 = silu_mul_sc(acc[ai][0][m][1], acc[ai][1][m][1], ke, km);
                if (OUT8) { u32x2 w8; w8.x = pk4_f8(v0); w8.y = pk4_f8(v1); *(u32x2*)((unsigned char*)O + (size_t)(row0 + ai * HALF + m * 16) * ldc + col0) = w8; }
                else *(u32x4*)(O + (size_t)(row0 + ai * HALF + m * 16) * ldc + col0) = pk8(v0, v1);
            }
    }
};
struct EpiScatter {
    static constexpr bool PERM = true, AFTER_DRAIN = false;
    bf16_t* Y; const int* rowmap; const float* roww; int sub; float sc;
    __device__ __forceinline__ void operator()(const f32x4 (&acc)[2][2][4][2], const Unit& u, int wr, int wc, int fr, int fq) const {
        const int row0 = u.pm * BM + wr * 64 + fr, col0 = (u.pn & 3) * BM + wc * 32 + 8 * fq;
#pragma unroll
        for (int ai = 0; ai < 2; ++ai)
#pragma unroll
            for (int m = 0; m < 4; ++m) {
                const int r = row0 + ai * HALF + m * 16; const int ts = rowmap[r];
                if (ts >= 0) { const float w = roww[r] * sc; bf16_t* rowp = Y + (size_t)(ts - sub) * D + col0;
#pragma unroll
                    for (int bj = 0; bj < 2; ++bj) *(u32x4*)(rowp + bj * HALF) = pk8(acc[ai][bj][m][0] * w, acc[ai][bj][m][1] * w); }
            }
    }
};
struct EpiScatterTail {
    static constexpr bool PERM = true, AFTER_DRAIN = false;
    bf16_t* YT; const float* roww; int kbytes; float sc;
    __device__ __forceinline__ void operator()(const f32x4 (&acc)[2][2][4][2], const Unit& u, int wr, int wc, int fr, int fq) const {
        const int row0 = u.pm * BM + wr * 64 + fr, col0 = (u.pn & 3) * BM + wc * 32 + 8 * fq; const int kq = u.ko / kbytes;
#pragma unroll
        for (int ai = 0; ai < 2; ++ai)
#pragma unroll
            for (int m = 0; m < 4; ++m) {
                const int r = row0 + ai * HALF + m * 16; const float w = roww[r] * sc; bf16_t* rowp = YT + ((size_t)kq * 2048 + (r - 64 * 256)) * D + col0;
#pragma unroll
                for (int bj = 0; bj < 2; ++bj) *(u32x4*)(rowp + bj * HALF) = pk8(acc[ai][bj][m][0] * w, acc[ai][bj][m][1] * w);
            }
    }
};
struct MoeOrder {
    const PG8_LAS int* tstart; int nN, G, c, maxpm;
    __device__ __forceinline__ bool next(int i, Unit& u) const {
        const int L = i * G + c; int T = tstart[8]; T = T < maxpm ? T : maxpm;
        const int nb = (T & ~7) * nN; int pm, j;
        if (L < nb) { const int b = L >> 5, r = L & 31, q4 = nN >> 2, g = b / q4; pm = 8 * g + (r & 7); j = 4 * (b - g * q4) + (r >> 3); }
        else { const int L2 = L - nb; pm = (T & ~7) + L2 / nN; j = L2 - (L2 / nN) * nN; }
        if (pm >= T) return false;
        int e = 0;
#pragma unroll
        for (int k = 1; k < 8; ++k) e += (pm >= tstart[k]) ? 1 : 0;
        u.pm = pm; u.pn = e * nN + j; u.ko = 0; return true;
    }
    __device__ __forceinline__ void a_ready(const Unit&) const {}
    __device__ __forceinline__ void done(const Unit&) const {}
};
struct MoeTailOrder {
    const PG8_LAS int* tstart; int G, c, pm0, kbytes, TS;
    __device__ __forceinline__ bool next(int i, Unit& u) const {
        const int L = i * G + c, t = L / TS, pm = pm0 + (t >> 2);
        if (pm >= tstart[8]) return false;
        int e = 0;
#pragma unroll
        for (int k = 1; k < 8; ++k) e += (pm >= tstart[k]) ? 1 : 0;
        u.pm = pm; u.pn = e * 4 + (t & 3); u.ko = (L - t * TS) * kbytes; return true;
    }
    __device__ __forceinline__ void a_ready(const Unit&) const {}
    __device__ __forceinline__ void done(const Unit&) const {}
};
template <class Epi, class Sched, bool ALIGN_EPI = false, bool SP2 = false, bool F8 = false>
__device__ __forceinline__ void gemm_phase(PG8_LAS unsigned char* lds, const Gemm g, const Sched& S, const Epi& E) {
    int tid_ = threadIdx.x; asm volatile("" : "+v"(tid_));
    const int tid = tid_, wid = __builtin_amdgcn_readfirstlane(tid >> 6), lane = tid & 63, wr = wid >> 2, wc = wid & 3, fr = lane & 15, fq = lane >> 4;
    const int K = g.ld, nt = g.K / BK;
    unsigned voffA[2], voffB[2];
#pragma unroll
    for (int i = 0; i < 2; ++i) { int R, C; stage_rc(tid * 16 + i * 8192, R, C); const int Rb = Epi::PERM ? ((R & ~31) + perm32(R & 31)) : R;
        voffA[i] = (unsigned)(R * K + C) * 2u; voffB[i] = (unsigned)(Rb * K + C) * 2u; }
    const size_t kstep = (size_t)(BK * 2);
    const size_t hstep = (size_t)HALF * K * 2;
    const size_t tstep = 2 * hstep;
    const unsigned ldsw = (unsigned)wid * 1024u;
    const int aoff = lds_byte(wr * 64 + fr, fq * 8), boff = lds_byte(wc * 32 + fr, fq * 8);
    int a8[2], b8[2];
#pragma unroll
    for (int p = 0; p < 2; ++p) { a8[p] = lds_byte(wr * 64 + fr, (fq >> 1) * 32 + 16 * (fq & 1) + 8 * p); b8[p] = lds_byte(wc * 32 + fr, (fq >> 1) * 32 + 16 * (fq & 1) + 8 * p); }
#define PG8_SA(b, h) (((b) * 2 + (h)) * HTB)
#define PG8_SB(b, h) ((4 + (b) * 2 + (h)) * HTB)
#define PG8_STAGE(bufoff, gbase, voff) do { _Pragma("unroll") for (int _i = 0; _i < 2; ++_i) \
        __builtin_amdgcn_global_load_lds((const unsigned*)((const char*)(gbase) + (voff)[_i]), (PG8_LAS unsigned*)(lds + (bufoff) + ldsw + _i * 8192), 16, 0, 0); } while (0)
#define PG8_LDA(dst, b, h) do { if constexpr (F8) { _Pragma("unroll") for (int m = 0; m < 4; ++m) dst##8[m] = *(const PG8_LAS v8i_t*)(lds + PG8_SA(b, h) + a8[0] + m * 2048); }     \
    else { _Pragma("unroll") for (int m = 0; m < 4; ++m) _Pragma("unroll") for (int k = 0; k < 2; ++k) dst[m][k] = *(const PG8_LAS bf16x8*)(lds + PG8_SA(b, h) + aoff + m * 2048 + k * 1024); } } while (0)
#define PG8_LDB(dst, b, h) do { if constexpr (F8) { _Pragma("unroll") for (int n = 0; n < 2; ++n) dst##8[n] = *(const PG8_LAS v8i_t*)(lds + PG8_SB(b, h) + b8[0] + n * 2048); } \
    else { _Pragma("unroll") for (int n = 0; n < 2; ++n) _Pragma("unroll") for (int k = 0; k < 2; ++k) dst[n][k] = *(const PG8_LAS bf16x8*)(lds + PG8_SB(b, h) + boff + n * 2048 + k * 1024); } } while (0)
#define PG8_CAT8(x0, x1) __builtin_shufflevector(__builtin_bit_cast(v4i_t, x0), __builtin_bit_cast(v4i_t, x1), 0, 1, 2, 3, 4, 5, 6, 7)
#define PG8_MMA(ai, bj, At, Bt) do { __builtin_amdgcn_s_setprio(1); if constexpr (F8) { _Pragma("unroll") for (int m = 0; m < 4; ++m) _Pragma("unroll") for (int n = 0; n < 2; ++n) \
        asm volatile("v_mfma_f32_16x16x128_f8f6f4 %0, %1, %2, %0" : "+v"(acc[ai][bj][m][n]) : "v"(Bt##8[n]), "v"(At##8[m])); } \
    else { _Pragma("unroll") for (int m = 0; m < 4; ++m) _Pragma("unroll") for (int n = 0; n < 2; ++n) _Pragma("unroll") for (int k = 0; k < 2; ++k) \
        acc[ai][bj][m][n] = __builtin_amdgcn_mfma_f32_16x16x32_bf16(Bt[n][k], At[m][k], acc[ai][bj][m][n], 0, 0, 0); } __builtin_amdgcn_s_setprio(0); } while (0)
#define PG8_WAIT_V(n) asm volatile("s_waitcnt vmcnt(" #n ")" ::: "memory")
#define PG8_WAIT_L(n) asm volatile("s_waitcnt lgkmcnt(" #n ")" ::: "memory")
#define PG8_BAR __builtin_amdgcn_s_barrier()
#define PG8_SCHED __builtin_amdgcn_sched_barrier(0)
    Unit cur, nxt; int ui = 0;
    if (!S.next(0, cur)) return;
    f32x4 acc[2][2][4][2];
#pragma unroll
    for (int a = 0; a < 2; ++a)
#pragma unroll
        for (int b = 0; b < 2; ++b)
#pragma unroll
            for (int m = 0; m < 4; ++m)
#pragma unroll
                for (int n = 0; n < 2; ++n) acc[a][b][m][n] = (f32x4){0.f, 0.f, 0.f, 0.f};
    bf16x8 At[4][2], B0[2][2], B1[2][2]; v8i_t At8[4], B08[2], B18[2];
    const char* cA = (const char*)g.A + (size_t)cur.pm * tstep + cur.ko; const char* cB = (const char*)g.Bt + (size_t)cur.pn * tstep + cur.ko;
    S.a_ready(cur);
    if constexpr (SP2) {
        PG8_STAGE(PG8_SB(0, 0), cB, voffB); PG8_STAGE(PG8_SB(0, 1), cB + hstep, voffB); PG8_STAGE(PG8_SA(0, 0), cA, voffA); PG8_STAGE(PG8_SA(0, 1), cA + hstep, voffA);
        if (wr == 1) PG8_BAR;
        PG8_WAIT_V(2); PG8_BAR;
        PG8_STAGE(PG8_SB(1, 0), cB + kstep, voffB); PG8_STAGE(PG8_SA(1, 0), cA + kstep, voffA); PG8_STAGE(PG8_SB(1, 1), cB + hstep + kstep, voffB);
        PG8_WAIT_V(6); PG8_BAR;
    } else {
        PG8_STAGE(PG8_SB(0, 0), cB, voffB); PG8_STAGE(PG8_SA(0, 0), cA, voffA); PG8_STAGE(PG8_SB(0, 1), cB + hstep, voffB); PG8_STAGE(PG8_SA(0, 1), cA + hstep, voffA);
        if (wr == 1) PG8_BAR;
        PG8_WAIT_V(4); PG8_BAR;
        PG8_STAGE(PG8_SB(1, 0), cB + kstep, voffB); PG8_STAGE(PG8_SA(1, 0), cA + kstep, voffA); PG8_STAGE(PG8_SB(1, 1), cB + hstep + kstep, voffB);
        PG8_WAIT_V(6); PG8_BAR;
    }
    for (;;) {
        const bool has_next = S.next(ui + 1, nxt);
        const char* nA = has_next ? (const char*)g.A + (size_t)nxt.pm * tstep + nxt.ko : cA; const char* nB = has_next ? (const char*)g.Bt + (size_t)nxt.pn * tstep + nxt.ko : cB;
        for (int t = 0; t < nt; t += 2) {
            const bool last = (t == nt - 2);
            const char* a1 = cA + (size_t)(t + 1) * kstep;
            const char* a2 = last ? nA : cA + (size_t)(t + 2) * kstep; const char* b2 = last ? nB : cB + (size_t)(t + 2) * kstep;
            const char* a3 = a2 + kstep; const char* b3 = b2 + kstep;
            if (last && has_next) S.a_ready(nxt);
            if constexpr (SP2) {
            PG8_LDB(B0, 0, 0); PG8_LDB(B1, 0, 1); PG8_SCHED; PG8_LDA(At, 0, 0); PG8_STAGE(PG8_SA(1, 1), a1 + hstep, voffA);
            PG8_WAIT_V(8); PG8_WAIT_L(0); PG8_BAR; PG8_MMA(0, 0, At, B0); PG8_MMA(0, 1, At, B1); PG8_BAR; PG8_SCHED;
            PG8_LDA(At, 0, 1); PG8_STAGE(PG8_SB(0, 0), b2, voffB); PG8_STAGE(PG8_SB(0, 1), b2 + hstep, voffB); PG8_STAGE(PG8_SA(0, 0), a2, voffA);
            PG8_WAIT_V(8); PG8_WAIT_L(0); PG8_BAR; PG8_MMA(1, 0, At, B0); PG8_MMA(1, 1, At, B1); PG8_BAR; PG8_SCHED;
            PG8_LDB(B0, 1, 0); PG8_LDB(B1, 1, 1); PG8_SCHED; PG8_LDA(At, 1, 0); PG8_STAGE(PG8_SA(0, 1), a2 + hstep, voffA);
            PG8_WAIT_V(8); PG8_WAIT_L(0); PG8_BAR; PG8_MMA(0, 0, At, B0); PG8_MMA(0, 1, At, B1); PG8_BAR; PG8_SCHED;
            PG8_LDA(At, 1, 1); PG8_STAGE(PG8_SB(1, 0), b3, voffB); PG8_STAGE(PG8_SB(1, 1), b3 + hstep, voffB); PG8_STAGE(PG8_SA(1, 0), a3, voffA);
            PG8_WAIT_V(8); PG8_WAIT_L(0); PG8_BAR; PG8_MMA(1, 0, At, B0); PG8_MMA(1, 1, At, B1); PG8_BAR; PG8_SCHED;
            } else {
            PG8_LDB(B0, 0, 0); PG8_SCHED; PG8_LDA(At, 0, 0); PG8_STAGE(PG8_SA(1, 1), a1 + hstep, voffA);
            PG8_WAIT_L(8); PG8_BAR; PG8_WAIT_L(0); PG8_MMA(0, 0, At, B0); PG8_BAR; PG8_SCHED;
            PG8_LDB(B1, 0, 1); PG8_STAGE(PG8_SB(0, 0), b2, voffB);
            PG8_BAR; PG8_WAIT_L(0); PG8_MMA(0, 1, At, B1); PG8_BAR;
            PG8_LDA(At, 0, 1); PG8_STAGE(PG8_SA(0, 0), a2, voffA);
            PG8_BAR; PG8_WAIT_L(0); PG8_MMA(1, 0, At, B0); PG8_BAR; PG8_SCHED;
            PG8_STAGE(PG8_SB(0, 1), b2 + hstep, voffB);
            PG8_WAIT_V(6); PG8_BAR; PG8_MMA(1, 1, At, B1); PG8_BAR;
            PG8_LDB(B0, 1, 0); PG8_SCHED; PG8_LDA(At, 1, 0); PG8_STAGE(PG8_SA(0, 1), a2 + hstep, voffA);
            PG8_WAIT_L(8); PG8_BAR; PG8_WAIT_L(0); PG8_MMA(0, 0, At, B0); PG8_BAR; PG8_SCHED;
            PG8_LDB(B1, 1, 1); PG8_STAGE(PG8_SB(1, 0), b3, voffB);
            PG8_BAR; PG8_WAIT_L(0); PG8_MMA(0, 1, At, B1); PG8_BAR;
            PG8_LDA(At, 1, 1); PG8_STAGE(PG8_SA(1, 0), a3, voffA);
            PG8_BAR; PG8_WAIT_L(0); PG8_MMA(1, 0, At, B0); PG8_BAR; PG8_SCHED;
            PG8_STAGE(PG8_SB(1, 1), b3 + hstep, voffB);
            PG8_WAIT_V(6); PG8_BAR; PG8_MMA(1, 1, At, B1); PG8_BAR;
            }
        }
        if constexpr (F8) asm volatile("s_nop 15\n\ts_nop 7" ::: "memory");
        if constexpr (ALIGN_EPI) { if (wr == 0) PG8_BAR; }
        if constexpr (!Epi::AFTER_DRAIN) { E(acc, cur, wr, wc, fr, fq); S.done(cur); }
        if (!has_next) break;
#pragma unroll
        for (int a = 0; a < 2; ++a)
#pragma unroll
            for (int b = 0; b < 2; ++b)
#pragma unroll
                for (int m = 0; m < 4; ++m)
#pragma unroll
                    for (int n = 0; n < 2; ++n) acc[a][b][m][n] = (f32x4){0.f, 0.f, 0.f, 0.f};
        cur = nxt; cA = nA; cB = nB; ++ui;
        if constexpr (ALIGN_EPI) { if (wr == 1) PG8_BAR; }
    }
    PG8_WAIT_V(0);
    if constexpr (!ALIGN_EPI) { if (wr == 0) PG8_BAR; }
    PG8_BAR;
    if constexpr (Epi::AFTER_DRAIN) { E.fused(acc, cur, wr, wc, fr, fq, lds, wid, lane); S.done(cur); }
#undef PG8_SA
#undef PG8_SB
#undef PG8_STAGE
#undef PG8_LDA
#undef PG8_LDB
#undef PG8_MMA
#undef PG8_CAT8
#undef PG8_WAIT_V
#undef PG8_WAIT_L
#undef PG8_BAR
#undef PG8_SCHED
}
}
#ifndef PG8_SP2
#define PG8_SP2 true
#endif
#ifndef PG8_ALIGN
#define PG8_ALIGN true
#endif
#ifndef MK_PER_PHASE
#define MK_PER_PHASE 0
#endif
constexpr size_t MiB = 1u << 20;
constexpr size_t WS_CTL = 0, CTL_ZERO_BYTES = 64 * 1024;
constexpr size_t WS_ADA = 1 * MiB;
constexpr size_t WS_SMALL = 2 * MiB;
constexpr size_t WS_GATES = 4 * MiB;
constexpr size_t WS_SCAN = 6 * MiB;
constexpr size_t WS_WIN = 8 * MiB;
constexpr size_t WS_WOUT = 22 * MiB;
constexpr size_t WS_WUP = 26 * MiB;
constexpr size_t WS_WDN = 37 * MiB;
constexpr size_t WS_MUP = 43 * MiB;
constexpr size_t WS_MDN = 155 * MiB;
constexpr size_t WS_XA = 211 * MiB;
constexpr size_t WS_Y = 247 * MiB;
constexpr size_t WS_QKV = 283 * MiB;
constexpr size_t WS_CAT = 409 * MiB;
constexpr size_t WS_H = 445 * MiB;
constexpr size_t WS_DC = 481 * MiB;
constexpr size_t WS_END = 517 * MiB;
constexpr size_t SM_ROPE = 0;
constexpr size_t SM_ROUTE = 16384;
constexpr size_t SM_ROWMAP = SM_ROUTE + (size_t)ML * 32;
constexpr size_t SM_ROWW = SM_ROWMAP + 2 * (size_t)MR * 4;
constexpr size_t SM_GTAB = 1280 * 1024;
constexpr size_t SM_RTAB = SM_GTAB + 2 * 16 * 1024 * 4;
static_assert(SM_ROWW + 2 * (size_t)MR * 4 <= SM_GTAB && SM_RTAB + 8 * 1024 * 4 <= 2 * MiB, "WS_SMALL map");
constexpr int SC_N = 2 * NB * 4 * TT;
constexpr int SC_ROW = 0, SC_COL = SC_N, SC_LMX = 2 * SC_N, SC_DN = 2 * SC_N + 1024;
constexpr int CW_CNT = 1024;
constexpr int CW_CVQ = 1536;
constexpr int CW_BAR = 4096;
static_assert((CW_BAR + 3456) * 4 <= (int)CTL_ZERO_BYTES, "control words inside the memset region");

constexpr int RING_BYTES = 131072;
constexpr int LDSCTL_OFF = RING_BYTES, MISC_OFF = LDSCTL_OFF + 320;
constexpr int SMALL_OFF = RING_BYTES + 1024;
constexpr int LDS_BYTES = 147456;
constexpr int NWAVES = 8;

#define GAS __attribute__((address_space(1)))
#define LAS __attribute__((address_space(3)))
#define DI __device__ __forceinline__
typedef unsigned short bf16;
typedef float f32x4 __attribute__((ext_vector_type(4)));
typedef float f32x16 __attribute__((ext_vector_type(16)));
typedef short bf16x8 __attribute__((ext_vector_type(8)));
typedef short s16x4 __attribute__((ext_vector_type(4)));
typedef unsigned u32x4 __attribute__((ext_vector_type(4)));
using pg8::u32x2;
typedef GAS unsigned gu32;
#define RLX_AGENT __ATOMIC_RELAXED, __HIP_MEMORY_SCOPE_AGENT
#define LDS_WAIT() asm volatile("s_waitcnt lgkmcnt(0)" ::: "memory")
using pg8::pk2;
DI float bf2f(unsigned h) { return __uint_as_float(h << 16); }
constexpr float F8_SA = 16.0f, F8_SW = 512.0f, F8_SH = 8.0f;
DI float f8clamp(float x) { return fminf(fmaxf(x, -448.0f), 448.0f); }
DI unsigned pk4_f8(float a, float b, float c, float d) { unsigned p = 0u; p = __builtin_amdgcn_cvt_pk_fp8_f32(f8clamp(a), f8clamp(b), p, false); p = __builtin_amdgcn_cvt_pk_fp8_f32(f8clamp(c), f8clamp(d), p, true); return p; }
DI float wave_sum(float v) {
#pragma unroll
    for (int o = 1; o < 64; o <<= 1) v += __shfl_xor(v, o);
    return v;
}
DI float wave_max(float v) {
#pragma unroll
    for (int o = 1; o < 64; o <<= 1) v = fmaxf(v, __shfl_xor(v, o));
    return v;
}

#define XB_TMO      128
#define XB_XCNT(j)  (256  + 64 * (j))
#define XB_XSUB(j)  (1280 + 64 * (j))
#define XB_XGEN(j)  (2304 + 64 * (j))
#define XB_TOP      3328
#define XB_TOPGEN   3392
#define XCD_BAR_WORDS 3456
#define XB_SPIN_CAP (1u << 18)
__device__ __forceinline__ unsigned xb_ld(unsigned* p)              { return __hip_atomic_load(p, __ATOMIC_RELAXED, __HIP_MEMORY_SCOPE_AGENT); }
__device__ __forceinline__ unsigned xb_add(unsigned* p, unsigned v) { return __hip_atomic_fetch_add(p, v, __ATOMIC_RELAXED, __HIP_MEMORY_SCOPE_AGENT); }
__device__ __forceinline__ unsigned xb_xcc_id() { return (unsigned)__builtin_amdgcn_s_getreg((3 << 11) | 20) & 0xFu; }
#define XB_SPIN(cond, bar) do { unsigned _sp = 0; while (cond) { __builtin_amdgcn_s_sleep(1); \
    if ((++_sp & 255u) == 0u) { if (xb_ld(&(bar)[XB_TMO])) break; if (_sp > XB_SPIN_CAP) { atomicAdd(&(bar)[XB_TMO], 1u); break; } } } } while (0)
struct XcdBarrier { unsigned* bar; unsigned x; volatile LAS unsigned* st; };
__device__ __forceinline__ XcdBarrier xcd_barrier_post(unsigned* bar, volatile LAS unsigned* st) {
    XcdBarrier b; b.bar = bar; b.x = xb_xcc_id(); b.st = st;
    if (threadIdx.x == 0) (void)xb_add(&bar[XB_XCNT(b.x)], 1u);
    return b;
}
__device__ __forceinline__ void xcd_barrier_complete(unsigned* bar, unsigned x, unsigned& nloc, unsigned& nx) {
    const unsigned G = gridDim.x * gridDim.y * gridDim.z;
    unsigned sum, cnt, mine, sp = 0u;
    for (;;) {
        sum = 0u; cnt = 0u; mine = 0u;
#pragma unroll
        for (unsigned j = 0; j < 16; ++j) { const unsigned c = xb_ld(&bar[XB_XCNT(j)]); sum += c; cnt += (c > 0u) ? 1u : 0u; mine = (j == x) ? c : mine; }
        if (sum == G) break;
        __builtin_amdgcn_s_sleep(1);
        if ((++sp & 255u) == 0u) { if (xb_ld(&bar[XB_TMO])) break; if (sp > XB_SPIN_CAP) { atomicAdd(&bar[XB_TMO], 1u); break; } }
    }
    nloc = mine > 0u ? mine : 1u; nx = cnt > 0u ? cnt : 1u;
}
__device__ __forceinline__ void xcd_barrier(const XcdBarrier& b) {
    asm volatile("s_waitcnt vmcnt(0)" ::: "memory");
    __syncthreads();
    if (threadIdx.x == 0) {
        unsigned* bar = b.bar;
        __builtin_amdgcn_s_waitcnt(0);
        unsigned nloc = b.st[0], nx = b.st[1];
        if (nloc == 0u) { xcd_barrier_complete(bar, b.x, nloc, nx); b.st[0] = nloc; b.st[1] = nx; }
        const unsigned old = xb_add(&bar[XB_XSUB(b.x)], 1u);
        const unsigned gen = old / nloc;
        if (old + 1u == (gen + 1u) * nloc) {
            __builtin_amdgcn_fence(__ATOMIC_RELEASE, "agent");
            asm volatile("s_waitcnt vmcnt(0)" ::: "memory");
            const unsigned og = xb_add(&bar[XB_TOP], 1u);
            const unsigned tg = og / nx;
            if (og + 1u == (tg + 1u) * nx) xb_add(&bar[XB_TOPGEN], 1u);
            else XB_SPIN(xb_ld(&bar[XB_TOPGEN]) == tg, bar);
            __builtin_amdgcn_fence(__ATOMIC_ACQUIRE, "agent");
            xb_add(&bar[XB_XGEN(b.x)], 1u);
            asm volatile("s_waitcnt vmcnt(0)" ::: "memory");
        } else {
            XB_SPIN(xb_ld(&bar[XB_XGEN(b.x)]) == gen, bar);
            __builtin_amdgcn_fence(__ATOMIC_ACQUIRE, "agent");
            asm volatile("s_waitcnt vmcnt(0)" ::: "memory");
        }
    }
    __syncthreads();
}

struct Args { const float* in[28]; float* out; unsigned char* ws; int ph_lo, ph_hi; };
typedef const Args __attribute__((address_space(4)))* KArgs;
DI KArgs kargs() { KArgs p = (KArgs)__builtin_amdgcn_kernarg_segment_ptr(); asm volatile("" : "+s"(p)); return p; }
struct Frame {
    LAS unsigned char* lds;
    int tid, lane, wave, vcu, G;
};
DI Frame fresh(const Frame& F0) { Frame F = F0; int l = (int)__builtin_amdgcn_mbcnt_hi(~0u, __builtin_amdgcn_mbcnt_lo(~0u, 0u)); asm volatile("" : "+v"(l)); F.lane = l; F.tid = F.wave * 64 + l; return F; }
enum { I_X = 0, I_C, I_CTX, I_CCTX, I_ADAW, I_ADAB, I_N1G, I_N2G, I_WIN, I_WOUT, I_QNG, I_KNG, I_LQ1, I_LK1, I_LQ2, I_LK2, I_SUBLN, I_CONVW, I_CONVB, I_GATEB, I_MNG,
       I_FW1, I_FW3, I_FW2, I_RW, I_MW1, I_MW3, I_MW2 };

template <bool NT = false, bool F8OUT = false>
DI void tr_item(const float* W, int ldw, int K, bf16* WT, int k0, int n0, int drow0, LAS float* scr, int lane) {
#pragma unroll 8
    for (int i = 0; i < 32; ++i) { const int kk = 2 * i + (lane >> 5); const float* src = &W[(size_t)(k0 + kk) * ldw + n0 + (lane & 31)]; scr[kk * 33 + (lane & 31)] = NT ? __builtin_nontemporal_load(src) : *src; }
    LDS_WAIT(); asm volatile("" ::: "memory");
    const int c = lane & 7;
#pragma unroll
    for (int j = 0; j < 4; ++j) { const int n = (lane >> 3) + 8 * j; const LAS float* s = scr + (8 * c) * 33 + n;
        if (F8OUT) {
            u32x2 o; o.x = pk4_f8(s[0 * 33] * F8_SW, s[1 * 33] * F8_SW, s[2 * 33] * F8_SW, s[3 * 33] * F8_SW); o.y = pk4_f8(s[4 * 33] * F8_SW, s[5 * 33] * F8_SW, s[6 * 33] * F8_SW, s[7 * 33] * F8_SW);
            u32x2* dst = (u32x2*)((unsigned char*)WT + (size_t)(drow0 + n) * K + k0 + 8 * c);
            if (NT) __builtin_nontemporal_store(o, dst); else *dst = o;
        } else {
        u32x4 o; o.x = pk2(s[0 * 33], s[1 * 33]); o.y = pk2(s[2 * 33], s[3 * 33]); o.z = pk2(s[4 * 33], s[5 * 33]); o.w = pk2(s[6 * 33], s[7 * 33]);
        u32x4* dst = (u32x4*)(WT + (size_t)(drow0 + n) * K + k0 + 8 * c);
        if (NT) __builtin_nontemporal_store(o, dst); else *dst = o; } }
    LDS_WAIT(); asm volatile("" ::: "memory");
}
DI int map_win(int n0) {
    if (n0 >= 1024) return n0;
    const int pn = n0 >> 8, o = n0 & 255, g = o >> 6, d = o & 63;
    return (pn << 8) + 128 * (d >> 5) + 32 * g;
}
DI int map_up(int n0, int third) { return 256 * (n0 >> 7) + 128 * third + (n0 & 127); }
constexpr int CV_IN = 16 * 112, CV_OUT = 16 * 32, CV_UP = 16 * 88, CV_DN = 44 * 32, CV_M13 = 16 * 112, CV_M2 = 56 * 32;
constexpr int CV_PRO = 2 * CV_IN + 2 * CV_OUT + 2 * CV_UP + CV_DN + 8300, CV_P4 = CV_PRO + 7500, CV_P6 = CV_P4 + 8400;
constexpr int CV_SMALL = 2 * CV_IN + 2 * CV_OUT + 2 * CV_UP + CV_DN, CV_ALL = CV_SMALL + 16 * CV_M13 + 8 * CV_M2;
DI void cvt_item(const KArgs ka, int it, LAS float* scr, int lane) {
    unsigned char* ws = ka->ws;
    int r = it;
    if (r < 2 * CV_IN) { const int l = r / CV_IN; r -= l * CV_IN; const int kb = r / 112, nb = r % 112;
        if (l == 0) tr_item(ka->in[I_WIN], INC, 1024, (bf16*)(ws + WS_WIN), 64 * kb, 32 * nb, map_win(32 * nb), scr, lane);
        else tr_item<false, true>(ka->in[I_WIN] + (size_t)1024 * INC, INC, 1024, (bf16*)(ws + WS_WIN) + (size_t)NQ * 1024, 64 * kb, 32 * nb, map_win(32 * nb), scr, lane);
        return; } r -= 2 * CV_IN;
    if (r < 2 * CV_OUT) { const int l = r / CV_OUT; r -= l * CV_OUT; const int kb = r / 32, nb = r % 32;
        tr_item(ka->in[I_WOUT] + (size_t)l * 1024 * 1024, 1024, 1024, (bf16*)(ws + WS_WOUT) + (size_t)l * 1024 * 1024, 64 * kb, 32 * nb, 32 * nb, scr, lane); return; } r -= 2 * CV_OUT;
    if (r < 2 * CV_UP) { const int th = r / CV_UP; r -= th * CV_UP; const int kb = r / 88, nb = r % 88;
        tr_item(ka->in[th ? I_FW3 : I_FW1], FF, 1024, (bf16*)(ws + WS_WUP), 64 * kb, 32 * nb, map_up(32 * nb, th), scr, lane); return; } r -= 2 * CV_UP;
    if (r < CV_DN) { const int kb = r / 32, nb = r % 32;
        tr_item(ka->in[I_FW2], 1024, FF, (bf16*)(ws + WS_WDN), 64 * kb, 32 * nb, 32 * nb, scr, lane); return; } r -= CV_DN;
    if (r < 16 * CV_M13) { const int th = r / (8 * CV_M13); r -= th * 8 * CV_M13; const int e = r / CV_M13; r -= e * CV_M13; const int kb = r / 112, nb = r % 112;
        tr_item<true, true>(ka->in[th ? I_MW3 : I_MW1] + (size_t)e * 1024 * FFE, FFE, 1024, (bf16*)(ws + WS_MUP), 64 * kb, 32 * nb, e * 2 * FFE + map_up(32 * nb, th), scr, lane); return; } r -= 16 * CV_M13;
    { const int e = r / CV_M2; r -= e * CV_M2; const int kb = r / 32, nb = r % 32;
        tr_item<true, true>(ka->in[I_MW2] + (size_t)e * FFE * 1024, 1024, FFE, (bf16*)(ws + WS_MDN), 64 * kb, 32 * nb, e * 1024 + 32 * nb, scr, lane); }
}
DI void p0_prologue(const Frame& F) {
    const KArgs ka = kargs(); unsigned char* ws = ka->ws;
    {
        LAS float* S = (LAS float*)F.lds;
        LAS float* P = (LAS float*)(F.lds + 36864);
        bool have = false;
        for (int it = F.vcu; it < 192; it += F.G) {
            if (!have) {
                for (int idx = F.tid; idx < 9 * 1024; idx += NWAVES * 64) { const int r = idx >> 10, i = idx & 1023; const float v = r < 8 ? ka->in[I_C][r * 1024 + i] : ka->in[I_CCTX][i]; S[idx] = v / (1.0f + expf(-v)); }
                __syncthreads(); have = true;
            }
            const int l = it / 96, col = (it % 96) * 64 + F.lane;
            const float* w = ka->in[I_ADAW] + (size_t)l * 1024 * ADA_LD + col;
            float acc[9];
#pragma unroll
            for (int r = 0; r < 9; ++r) acc[r] = 0.f;
            const int kb = F.wave * 128;
#pragma unroll 16
            for (int k = 0; k < 128; ++k) { const float wv = w[(size_t)(kb + k) * ADA_LD];
#pragma unroll
                for (int r = 0; r < 9; ++r) acc[r] += S[r * 1024 + kb + k] * wv; }
#pragma unroll
            for (int r = 0; r < 9; ++r) P[(F.wave * 9 + r) * 64 + F.lane] = acc[r];
            __syncthreads();
            for (int idx = F.tid; idx < 9 * 64; idx += NWAVES * 64) { const int r = idx >> 6, ln = idx & 63; float s = 0.f;
#pragma unroll
                for (int w8 = 0; w8 < 8; ++w8) s += P[(w8 * 9 + r) * 64 + ln];
                const int c2 = (it % 96) * 64 + ln;
                ((float*)(ws + WS_ADA))[l * ADA_L + r * ADA_LD + c2] = s + ka->in[I_ADAB][l * ADA_LD + c2]; }
            __syncthreads();
        }
        __syncthreads();
    }
    if (F.vcu >= 1 && F.vcu <= 5) {
        float* gt = (float*)(ws + WS_SMALL + SM_GTAB); float* rt = (float*)(ws + WS_SMALL + SM_RTAB);
        for (int idx = (F.vcu - 1) * NWAVES * 64 + F.tid; idx < 2 * 16384 + 8192; idx += 5 * NWAVES * 64) {
            if (idx < 2 * 16384) { const int l = idx >> 14, k = (idx >> 4) & 1023, g = idx & 15; gt[l * 16384 + g * 1024 + k] = ka->in[I_WIN][(size_t)l * 1024 * INC + (size_t)k * INC + NQ + g]; }
            else { const int r = idx - 2 * 16384, k = r >> 3, e = r & 7; rt[e * 1024 + k] = ka->in[I_RW][k * NE + e]; }
        }
    }
    if (F.vcu == 0) {
        float* rr = (float*)(ws + WS_SMALL + SM_ROPE);
        for (int idx = F.tid; idx < 96 * 16; idx += NWAVES * 64) { const int p = idx >> 4, i = idx & 15;
            const float inv = exp2f(-(float)i * (13.287712379549449f / 16.0f)); const float pos = (float)(p < 32 ? p : p - 32); const float ang = pos * inv;
            rr[p * 32 + 2 * i] = cosf(ang); rr[p * 32 + 2 * i + 1] = sinf(ang); }
    }
    LAS float* scr = (LAS float*)(F.lds + F.wave * 16384);
    const int gw = F.vcu * NWAVES + F.wave, NGW = F.G * NWAVES;
    constexpr int CV_HEAD = 2048;
    if (F.G > 192 && F.vcu >= 192) for (int it = (F.vcu - 192) * NWAVES + F.wave; it < CV_HEAD; it += (F.G - 192) * NWAVES) cvt_item(ka, it, scr, F.lane);
    for (int it = (F.G > 192 ? CV_HEAD : 0) + gw; it < CV_PRO; it += NGW) cvt_item(ka, it, scr, F.lane);
}
DI void idle_convert(const Frame& F, int nunits, int lo, int hi) {
    const int r = nunits % F.G, c = (int)blockIdx.x;
    if (r == 0 || c < r) return;
    const KArgs ka = kargs();
    LAS float* scr = (LAS float*)(F.lds + F.wave * 16384);
    const int gw = (c - r) * NWAVES + F.wave, NGW = (F.G - r) * NWAVES;
    for (int it = lo + gw; it < hi; it += NGW) cvt_item(ka, it, scr, F.lane);
}
template <int NV, int SH, int N> DI void bfly_step(float (&part)[N], int lane) {
    const bool up = (lane & SH) != 0;
#pragma unroll
    for (int g = 0; g < NV; ++g) { const float keep = up ? part[g + NV] : part[g], give = up ? part[g] : part[g + NV]; part[g] = keep + __shfl_xor(give, SH); }
}
template <int KIND, bool SRCBF, bool OUT8 = (KIND == 2)>
DI void modulate_phase(const Frame& F, const void* srcL, const void* srcC, int nrows, const float* gam, const float* ada  , int off_sh, int off_sc,
                       bf16* H, const float* wtab  , float* gates, unsigned char* ws,
                       const bf16* extraC = nullptr  , bf16* wbC = nullptr  ) {
    constexpr int NT = KIND == 0 ? 16 : (KIND == 2 ? 8 : 0);
    LAS float* tab = (LAS float*)F.lds;
    if (NT) {
        for (int idx = F.tid; idx < NT * 256; idx += NWAVES * 64) *(LAS f32x4*)(tab + 4 * idx) = *(const f32x4*)(wtab + 4 * idx);
        __syncthreads();
    }
    const int gw = F.vcu * NWAVES + F.wave, NGW = F.G * NWAVES;
    LAS unsigned* lc = (LAS unsigned*)(F.lds + SMALL_OFF + 256);
    LAS unsigned* rl = (LAS unsigned*)(F.lds + SMALL_OFF + 512);
    if (KIND == 2) { int t_ = F.tid; asm volatile("" : "+v"(t_)); if (t_ < 32) lc[t_] = 0u; __syncthreads(); }
    int kk = 0;
    f32x4 nxt[4];
#define MOD_LOAD(r_) do { const int r2_ = (r_) < nrows ? (r_) : gw; const size_t ro_ = (r2_ < ML ? (size_t)r2_ * D : (size_t)(r2_ - ML) * D) + 4 * F.lane; const void* sb_ = r2_ < ML ? srcL : srcC; \
        _Pragma("unroll") for (int j = 0; j < 4; ++j) { if (SRCBF) { const u32x2 r_2 = *(const u32x2*)((const bf16*)sb_ + ro_ + 256 * j); \
                nxt[j] = (f32x4){__uint_as_float(r_2.x << 16), __uint_as_float(r_2.x & 0xffff0000u), __uint_as_float(r_2.y << 16), __uint_as_float(r_2.y & 0xffff0000u)}; } \
            else nxt[j] = *(const f32x4*)((const float*)sb_ + ro_ + 256 * j); } } while (0)
    if (gw < nrows) MOD_LOAD(gw);
    for (int row = gw; row < nrows; row += NGW, ++kk) {
        const int bsel = row < ML ? (row >> 11) : 8;
        const float* sh = ada + bsel * ADA_LD + off_sh + 4 * F.lane; const float* sc = ada + bsel * ADA_LD + off_sc + 4 * F.lane; const float* gm = gam + 4 * F.lane;
        f32x4 v[4]; float ss = 0.f;
#pragma unroll
        for (int j = 0; j < 4; ++j) v[j] = nxt[j];
        MOD_LOAD(row + NGW);
        if (extraC && row >= ML) {
#pragma unroll
            for (int j = 0; j < 4; ++j) { const u32x2 e2 = *(const u32x2*)(extraC + (size_t)(row - ML) * D + 4 * F.lane + 256 * j);
                v[j] = v[j] + (f32x4){__uint_as_float(e2.x << 16), __uint_as_float(e2.x & 0xffff0000u), __uint_as_float(e2.y << 16), __uint_as_float(e2.y & 0xffff0000u)};
                if (wbC) { u32x2 w2; w2.x = pk2(v[j][0], v[j][1]); w2.y = pk2(v[j][2], v[j][3]); *(u32x2*)(wbC + (size_t)(row - ML) * D + 4 * F.lane + 256 * j) = w2; } }
        }
#pragma unroll
        for (int j = 0; j < 4; ++j) ss += (v[j][0] * v[j][0] + v[j][1] * v[j][1]) + (v[j][2] * v[j][2] + v[j][3] * v[j][3]);
        const float rstd = 1.0f / sqrtf(wave_sum(ss) * (1.0f / D) + EPS);
#pragma unroll
        for (int j = 0; j < 4; ++j) { const f32x4 g4 = *(const f32x4*)(gm + 256 * j), s4 = *(const f32x4*)(sc + 256 * j), h4 = *(const f32x4*)(sh + 256 * j);
            v[j] = v[j] * rstd * g4 * (s4 + 1.0f) + h4; }
        if (OUT8) {
#pragma unroll
            for (int j = 0; j < 4; ++j) *(unsigned*)((unsigned char*)H + (size_t)row * D + 4 * F.lane + 256 * j) = pk4_f8(v[j][0] * F8_SA, v[j][1] * F8_SA, v[j][2] * F8_SA, v[j][3] * F8_SA);
        } else {
        u32x2* o8 = (u32x2*)(H + (size_t)row * D) + F.lane;
#pragma unroll
        for (int j = 0; j < 4; ++j) { u32x2 w; w.x = pk2(v[j][0], v[j][1]); w.y = pk2(v[j][2], v[j][3]); o8[64 * j] = w; }
        }
        if (NT) {
            float part[NT > 0 ? NT : 1];
#pragma unroll
            for (int g = 0; g < NT; ++g) { float s = 0.f;
#pragma unroll
                for (int j = 0; j < 4; ++j) { const f32x4 w4 = *(const LAS f32x4*)(tab + g * 1024 + 4 * F.lane + 256 * j); s += (v[j][0] * w4[0] + v[j][1] * w4[1]) + (v[j][2] * w4[2] + v[j][3] * w4[3]); }
                part[g] = s;
                if ((g & 3) == 3) asm volatile("" : "+v"(part[g - 3]), "+v"(part[g - 2]), "+v"(part[g - 1]), "+v"(part[g])); }
            bfly_step<(NT >> 1), 32, (NT > 0 ? NT : 1)>(part, F.lane);
            bfly_step<(NT >> 2), 16, (NT > 0 ? NT : 1)>(part, F.lane);
            bfly_step<(NT >> 3), 8, (NT > 0 ? NT : 1)>(part, F.lane);
            if (NT == 16) bfly_step<1, 4, (NT > 0 ? NT : 1)>(part, F.lane);
            float mine = part[0];
#pragma unroll
            for (int o = (NT == 16 ? 2 : 4); o >= 1; o >>= 1) mine += __shfl_xor(mine, o);
            if (KIND == 0) {
                const int gidx = ((F.lane >> 5) & 1) * 8 + ((F.lane >> 4) & 1) * 4 + ((F.lane >> 3) & 1) * 2 + ((F.lane >> 2) & 1);
                if ((F.lane & 3) == 0) gates[(size_t)row * 16 + gidx] = mine;
            } else {
                const int eidx = ((F.lane >> 5) & 1) * 4 + ((F.lane >> 4) & 1) * 2 + ((F.lane >> 3) & 1);
                float v0 = mine; int i0 = eidx;
#pragma unroll
                for (int o = 8; o < 64; o <<= 1) { const float ov = __shfl_xor(v0, o); const int oi = __shfl_xor(i0, o); if (ov > v0 || (ov == v0 && oi < i0)) { v0 = ov; i0 = oi; } }
                float v1 = (eidx == i0) ? -INFINITY : mine; int i1 = eidx;
#pragma unroll
                for (int o = 8; o < 64; o <<= 1) { const float ov = __shfl_xor(v1, o); const int oi = __shfl_xor(i1, o); if (ov > v1 || (ov == v1 && oi < i1)) { v1 = ov; i1 = oi; } }
                if (F.lane == 0) {
                    const float w0 = 1.0f / (1.0f + expf(v1 - v0)), w1 = 1.0f - w0;
                    const int half = row >> 13;
                    unsigned p0, p1;
                    if (kk < 16) { p0 = __hip_atomic_fetch_add(lc + half * 8 + i0, 1u, __ATOMIC_RELAXED, __HIP_MEMORY_SCOPE_WORKGROUP); p1 = __hip_atomic_fetch_add(lc + half * 8 + i1, 1u, __ATOMIC_RELAXED, __HIP_MEMORY_SCOPE_WORKGROUP);
                        LAS unsigned* r = rl + (F.wave * 16 + kk) * 8; r[0] = (unsigned)i0; r[1] = (unsigned)i1; r[2] = p0; r[3] = p1; r[4] = __float_as_uint(w0); r[5] = __float_as_uint(w1); }
                    else { unsigned* cnt = (unsigned*)(ws + WS_CTL) + CW_CNT + half * 8; p0 = atomicAdd(cnt + i0, 1u); p1 = atomicAdd(cnt + i1, 1u);
                        u32x4* rec = (u32x4*)(ws + WS_SMALL + SM_ROUTE + (size_t)row * 32);
                        rec[0] = (u32x4){(unsigned)i0, (unsigned)i1, p0, p1}; rec[1] = (u32x4){__float_as_uint(w0), __float_as_uint(w1), 0u, 0u}; }
                }
            }
        }
    }
#undef MOD_LOAD
    if (KIND == 2) {
        __syncthreads();
        if (F.tid < 16) lc[16 + F.tid] = atomicAdd((unsigned*)(ws + WS_CTL) + CW_CNT + F.tid, lc[F.tid]);
        __syncthreads();
        if (F.lane == 0) { int k2 = 0;
            for (int row = gw; row < nrows && k2 < 16; row += NGW, ++k2) { const LAS unsigned* r = rl + (F.wave * 16 + k2) * 8; const int half = row >> 13;
                u32x4* rec = (u32x4*)(ws + WS_SMALL + SM_ROUTE + (size_t)row * 32);
                rec[0] = (u32x4){r[0], r[1], r[2] + lc[16 + half * 8 + r[0]], r[3] + lc[16 + half * 8 + r[1]]}; rec[1] = (u32x4){r[4], r[5], 0u, 0u}; } }
    }
}

DI void conv_phase(const Frame& F, const bf16* QKV, bf16* MQK, const float* cw, const float* cb) {
    const int tg = F.tid >> 6, cg = F.tid & 63;
    for (int it = F.vcu; it < MR / 64; it += F.G) {
        const int c0 = 8 * cg;
        const int r0 = it * 64 + tg * 8;
        const int seqlen = r0 < ML ? T : CT, sbase = r0 < ML ? (r0 & ~(T - 1)) : ML + ((r0 - ML) & ~(CT - 1));
        const int t0 = r0 - sbase;
        u32x4 raw[12];
#pragma unroll
        for (int j = 0; j < 12; ++j) { const int t = t0 - 2 + j; const bool inr = t >= 0 && t < seqlen; const int tc = t < 0 ? 0 : (t >= seqlen ? seqlen - 1 : t);
            raw[j] = *(const u32x4*)(QKV + (size_t)(sbase + tc) * NQ + 1536 + c0); if (!inr) raw[j] = (u32x4){0u, 0u, 0u, 0u}; }
        const float osc = c0 >= 512 ? 0.08838834764831845f : 1.0f;
        float acc[8][8];
        { const f32x4 a = *(const f32x4*)(cb + c0), b = *(const f32x4*)(cb + c0 + 4);
#pragma unroll
          for (int k = 0; k < 8; ++k)
#pragma unroll
              for (int i = 0; i < 4; ++i) { acc[k][i] = a[i]; acc[k][4 + i] = b[i]; } }
#pragma unroll
        for (int j = 0; j < 5; ++j) {
            const f32x4 wa = *(const f32x4*)(cw + j * 1024 + c0), wb = *(const f32x4*)(cw + j * 1024 + c0 + 4);
#pragma unroll
            for (int k = 0; k < 8; ++k) { const u32x4 r = raw[k + j];
#pragma unroll
                for (int i = 0; i < 4; ++i) { const float wl = i < 2 ? wa[2 * i] : wb[2 * i - 4], wh = i < 2 ? wa[2 * i + 1] : wb[2 * i - 3];
                    acc[k][2 * i] += wl * bf2f(r[i] & 0xffffu); acc[k][2 * i + 1] += wh * bf2f(r[i] >> 16); } }
        }
#pragma unroll
        for (int k = 0; k < 8; ++k) { float y[8];
#pragma unroll
            for (int i = 0; i < 8; ++i) { const float sv = acc[k][i]; y[i] = sv * __builtin_amdgcn_rcpf(1.0f + __builtin_amdgcn_exp2f(-LOG2E * sv)) * osc; }
            u32x4 o; o.x = pk2(y[0], y[1]); o.y = pk2(y[2], y[3]); o.z = pk2(y[4], y[5]); o.w = pk2(y[6], y[7]);
            *(u32x4*)(MQK + (size_t)(r0 + k) * D + c0) = o; }
    }
}
DI float log_sigmoid(float g) { return fminf(g, 0.f) - log1pf(expf(-fabsf(g))); }
DI void scan_phase(const Frame& F, const float* gates, const float* gb  , float* scan) {
    LAS float* xs = (LAS float*)(F.lds + SMALL_OFF + 512);
    const int hw = F.wave >> 2, w4 = F.wave & 3, t256 = F.tid & 255;
    for (int it = F.vcu; it < 32; it += F.G) {
        const int ch = 2 * it + hw;
        const int dir = ch >> 5, b = (ch >> 2) & 7, h = ch & 3;
        const float bi = gb[dir * 8 + h], bf_ = gb[dir * 8 + 4 + h];
        const int gi = dir * 8 + h, gf = dir * 8 + 4 + h;
        float li[9], lf[9]; float tot = 0.f, lmx = 0.f;
#pragma unroll
        for (int k = 0; k < 9; ++k) { const int p = 9 * t256 + k;
            int row; if (dir == 0) row = p < CT ? ML + b * CT + p : b * T + (p - CT); else row = p < T ? b * T + p : ML + b * CT + (p - T);
            li[k] = gates[(size_t)row * 16 + gi] + bi; lf[k] = gates[(size_t)row * 16 + gf] + bf_; }
#pragma unroll
        for (int k = 0; k < 9; ++k) { lf[k] = log_sigmoid(lf[k]); tot += lf[k]; lmx = fmaxf(lmx, li[k]); }
        lmx = wave_max(lmx);
        float incl = tot;
#pragma unroll
        for (int o = 1; o < 64; o <<= 1) { const float n = __shfl_up(incl, o); if (F.lane >= o) incl += n; }
        if (F.lane == 63) xs[(hw * 4 + w4) * 2] = incl;
        if (F.lane == 0) xs[(hw * 4 + w4) * 2 + 1] = lmx;
        __syncthreads();
        float run = incl - tot;
#pragma unroll
        for (int w = 0; w < 4; ++w) { if (w < w4) run += xs[(hw * 4 + w) * 2]; lmx = fmaxf(lmx, xs[(hw * 4 + w) * 2 + 1]); }
        float* ROW = scan + SC_ROW + (size_t)ch * TT; float* COL = scan + SC_COL + (size_t)ch * TT;
#pragma unroll
        for (int k = 0; k < 9; ++k) { const int p = 9 * t256 + k;
            const int u = dir == 0 ? p : (p < T ? CT + p : p - T);
            if (dir == 0) { run += lf[k]; ROW[u] = run * LOG2E; COL[u] = (run - li[k] + lmx) * LOG2E; }
            else { ROW[u] = -run * LOG2E; COL[u] = (-run - li[k] + lmx) * LOG2E; run += lf[k]; } }
        if (t256 == 0) scan[SC_LMX + ch] = lmx;
        __syncthreads();
    }
}

DI s16x4 vtr_(const LAS unsigned char* p) { typedef short v4i16_t __attribute__((ext_vector_type(4))); return __builtin_bit_cast(s16x4, __builtin_amdgcn_ds_read_tr16_b64_v4i16((LAS v4i16_t*)p)); }
DI void mstate_unit(const Frame& F, const bf16* QKV, bf16* MQK, const float* scan, const float* cw  , const float* cb, float* DC, int b, int h, int k, int dir) {
    const int tid = F.tid, lane = F.lane, wid = F.wave, hi = lane >> 5;
    LAS unsigned char* lds = F.lds;
    const int c16 = tid & 15, tgrp = tid >> 4;
    const int ch0 = h * 128 + 8 * c16;
    const int seqrow0 = k == 0 ? ML + b * CT : b * T, seqlen = k == 0 ? CT : T, tchunk = k == 0 ? 0 : 256 * (k - 1);
    const int chn = dir * 32 + b * 4 + h;
    const float ref = scan[SC_ROW + (size_t)chn * TT + 256 * k + (dir ? 0 : 255)];
    const float* cwk = cw + 512 + ch0; const float* cbk = cb + 512 + ch0;
    const bool wrk = dir == 0 || k == 8;
    const int dkb = wid & 3, dvg = wid >> 2;
    f32x16 acc[3];
#pragma unroll
    for (int d = 0; d < 3; ++d)
#pragma unroll
        for (int i = 0; i < 16; ++i) acc[d][i] = 0.f;
    const unsigned vbn = ((lane >> 4) & 1) * 32 + (lane & 3) * 8 + (8 * hi + ((lane & 15) >> 2)) * 64;
    f32x4 wa[5], wb[5], ba, bb;
#pragma unroll
    for (int j = 0; j < 5; ++j) { wa[j] = *(const f32x4*)(cwk + j * 1024); wb[j] = *(const f32x4*)(cwk + j * 1024 + 4); }
    ba = *(const f32x4*)cbk; bb = *(const f32x4*)(cbk + 4);
#pragma unroll 1
    for (int sub = 0; sub < 2; ++sub) {
        const int tl0 = 128 * sub + 4 * tgrp;
        u32x4 raw[8], vv[4];
#pragma unroll
        for (int j = 0; j < 8; ++j) { const int t = tchunk + tl0 - 2 + j; const int tc = t < 0 ? 0 : (t >= seqlen ? seqlen - 1 : t);
            raw[j] = *(const u32x4*)(QKV + (size_t)(seqrow0 + tc) * NQ + 2048 + ch0); if (t < 0 || t >= seqlen) raw[j] = (u32x4){0u, 0u, 0u, 0u}; }
#pragma unroll
        for (int q = 0; q < 4; ++q) vv[q] = *(const u32x4*)(QKV + (size_t)(seqrow0 + tchunk + tl0 + q) * NQ + 2560 + ch0);
        const f32x4 col4 = *(const f32x4*)(scan + SC_COL + (size_t)chn * TT + 256 * k + tl0);
#pragma unroll
        for (int q = 0; q < 4; ++q) {
            float y[8];
#pragma unroll
            for (int i = 0; i < 4; ++i) { y[i] = ba[i]; y[4 + i] = bb[i]; }
#pragma unroll
            for (int j = 0; j < 5; ++j)
#pragma unroll
                for (int i = 0; i < 8; ++i) { const unsigned rw = raw[q + j][i >> 1]; y[i] += (i < 4 ? wa[j][i] : wb[j][i - 4]) * bf2f((i & 1) ? (rw >> 16) : (rw & 0xffffu)); }
#pragma unroll
            for (int i = 0; i < 8; ++i) { const float sv = y[i]; y[i] = sv * __builtin_amdgcn_rcpf(1.0f + __builtin_amdgcn_exp2f(-LOG2E * sv)) * 0.08838834764831845f; }
            if (wrk) { u32x4 ok; ok.x = pk2(y[0], y[1]); ok.y = pk2(y[2], y[3]); ok.z = pk2(y[4], y[5]); ok.w = pk2(y[6], y[7]); *(u32x4*)(MQK + (size_t)(seqrow0 + tchunk + tl0 + q) * D + 512 + ch0) = ok; }
            const float us = __builtin_amdgcn_exp2f(ref - col4[q]);
            u32x4 of;
#pragma unroll
            for (int i = 0; i < 4; ++i) of[i] = pk2(y[2 * i] * us, y[2 * i + 1] * us);
            const unsigned ka = (c16 >> 2) * 8192 + (4 * tgrp + q) * 64 + (c16 & 3) * 16;
            *(LAS u32x4*)(lds + ka) = of; *(LAS u32x4*)(lds + 32768 + ka) = vv[q];
        }
        { const int tok = tid >> 2, pc = tid & 3;
          *(LAS u32x4*)(lds + 32768 + 4 * 8192 + tok * 64 + pc * 16) = (u32x4){pc == 0 ? 0x3F80u : 0u, 0u, 0u, 0u}; }
        __syncthreads();
        const LAS unsigned char* Kb_ = lds + dkb * 8192 + vbn; const LAS unsigned char* Vb_ = lds + 32768 + vbn;
#pragma unroll 2
        for (int ks = 0; ks < 8; ++ks) {
            const s16x4 al = vtr_(Kb_ + ks * 1024), ah = vtr_(Kb_ + ks * 1024 + 256);
            const bf16x8 af = __builtin_shufflevector(al, ah, 0, 1, 2, 3, 4, 5, 6, 7);
#pragma unroll
            for (int d = 0; d < 3; ++d) { const int blk = dvg == 0 ? (d == 2 ? 4 : d) : (d == 2 ? 3 : 2 + d);
                if (dvg == 1 && d == 2) continue;
                const s16x4 bl = vtr_(Vb_ + blk * 8192 + ks * 1024), bh = vtr_(Vb_ + blk * 8192 + ks * 1024 + 256);
                acc[d] = __builtin_amdgcn_mfma_f32_32x32x16_bf16(af, __builtin_shufflevector(bl, bh, 0, 1, 2, 3, 4, 5, 6, 7), acc[d], 0, 0, 0); }
        }
        __syncthreads();
    }
    const int r32 = lane & 31;
    float* dc = DC + ((size_t)(chn * 9 + k) << 14);
    float* dn = (float*)scan + SC_DN + (chn * 9 + k) * 128;
#pragma unroll
    for (int i = 0; i < 16; ++i) { const int dk = 32 * dkb + (i & 3) + 8 * (i >> 2) + 4 * hi;
        if (dvg == 0) { dc[dk * 128 + r32] = acc[0][i]; dc[dk * 128 + 32 + r32] = acc[1][i]; if (r32 == 0) dn[dk] = acc[2][i]; }
        else { dc[dk * 128 + 64 + r32] = acc[0][i]; dc[dk * 128 + 96 + r32] = acc[1][i]; } }
}
DI void mprefix_phase(const Frame& F, float* scan, float* DC) {
    for (int it = F.vcu; it < 256; it += F.G) {
        const int ch = it >> 2, part = it & 3, dir = ch >> 5;
        const float* ROW = scan + SC_ROW + (size_t)ch * TT;
        float* base = DC + ((size_t)(ch * 9) << 14) + part * 4096 + F.tid * 8;
        float* nb = scan + SC_DN + ch * 9 * 128 + (F.tid & 127);
        const bool don = part == 0 && F.tid < 128;
        f32x4 x0[9], x1[9]; float xn[9], G[9];
#pragma unroll
        for (int k = 0; k < 9; ++k) { const float* p = base + ((size_t)k << 14); x0[k] = *(const f32x4*)p; x1[k] = *(const f32x4*)(p + 4); xn[k] = don ? nb[k * 128] : 0.f; }
        if (dir == 0) {
#pragma unroll
            for (int k = 1; k < 8; ++k) G[k] = __builtin_amdgcn_exp2f(ROW[256 * k + 255] - ROW[256 * k - 1]);
#pragma unroll
            for (int k = 1; k < 8; ++k) { x0[k] = x0[k - 1] * G[k] + x0[k]; x1[k] = x1[k - 1] * G[k] + x1[k]; xn[k] = xn[k - 1] * G[k] + xn[k];
                float* p = base + ((size_t)k << 14); *(f32x4*)p = x0[k]; *(f32x4*)(p + 4) = x1[k]; if (don) nb[k * 128] = xn[k]; }
        } else {
#pragma unroll
            for (int k = 2; k < 9; ++k) G[k] = __builtin_amdgcn_exp2f(ROW[256 * k] - ROW[256 * (k == 8 ? 0 : k + 1)]);
#pragma unroll
            for (int k = 8; k >= 2; --k) { const int nx = k == 8 ? 0 : k + 1;
                x0[k] = x0[nx] * G[k] + x0[k]; x1[k] = x1[nx] * G[k] + x1[k]; xn[k] = xn[nx] * G[k] + xn[k];
                float* p = base + ((size_t)k << 14); *(f32x4*)p = x0[k]; *(f32x4*)(p + 4) = x1[k]; if (don) nb[k * 128] = xn[k]; }
        }
    }
}
DI int crow(int r, int hi) { return (r & 3) + 8 * (r >> 2) + 4 * hi; }
DI s16x4 vtr(const LAS unsigned char* p) { typedef short v4i16_t __attribute__((ext_vector_type(4))); return __builtin_bit_cast(s16x4, __builtin_amdgcn_ds_read_tr16_b64_v4i16((LAS v4i16_t*)p)); }
DI bf16x8 pack8(const f32x16& x, int s) {
    u32x4 p; p.x = pk2(x[8 * s], x[8 * s + 1]); p.y = pk2(x[8 * s + 2], x[8 * s + 3]); p.z = pk2(x[8 * s + 4], x[8 * s + 5]); p.w = pk2(x[8 * s + 6], x[8 * s + 7]);
    return __builtin_bit_cast(bf16x8, p);
}
struct MixArgs {
    const bf16* QKV; const bf16* MQK; bf16* CAT; const float* scan; const float* DC;
    const float* gain;
    float lam, post, negm;
};
template <int MODE>
DI void mix_unit(const Frame& F, const MixArgs& A, int b, int h, int qt, bool isctx) {
    constexpr int KS = MODE == 0 ? 4 : 8;
    int lane_ = F.lane; asm volatile("" : "+v"(lane_));
    const int lane = lane_, wid = F.wave, tid = wid * 64 + lane, r32 = lane & 31, hi = lane >> 5;
    const int side = MODE == 0 ? (wid & 1) : (wid >> 2), qblk = MODE == 0 ? (wid >> 1) : (wid & 3);
    LAS unsigned char* lds = F.lds;
    const int qrow0 = (isctx ? ML + b * CT : b * T) + 128 * qt + 32 * qblk;
    const int kq = isctx ? 0 : 1 + (qt >> 1);
    const int jlo = MODE == 0 ? (isctx ? 32 : 0) : 4 * kq, jhi = MODE == 0 ? 36 : 4 * kq + 4;
    const int jd = MODE == 1 ? ((isctx ? 0 : 4) + 2 * qt + (qblk >> 1)) : 0;
    const bf16* Ksrc = MODE == 0 ? A.QKV + 512 + h * 128 : A.MQK + 512 + h * 128; const int Kld = MODE == 0 ? NQ : D;
    const bf16* Vsrc = A.QKV + (MODE == 0 ? 1024 : 2560) + h * 128;
    const int key0 = tid >> 4, c16 = tid & 15;
    const unsigned kdst0 = c16 * 1024 + ((key0 ^ c16) << 4), kdst1 = c16 * 1024 + (((key0 + 32) ^ c16) << 4);
    const unsigned vdst0 = 16384 + (c16 >> 2) * 4096 + (key0 ^ (c16 >> 2)) * 64 + (c16 & 3) * 16, vdst1 = vdst0 + 32 * 64;
    const float* colsrc = A.scan + SC_COL + (size_t)((wid & 1) * 32 + b * 4 + h) * TT;
    const unsigned koff0 = (unsigned)(key0 * Kld + 8 * c16) * 2u, koff1 = koff0 + 64u * (unsigned)Kld, voff0 = (unsigned)(key0 * NQ + 8 * c16) * 2u, voff1 = voff0 + 64u * (unsigned)NQ;
#define TILE_ROW0(j) (MODE == 0 ? ((j) < 32 ? b * T + 64 * (j) : ML + b * CT + 64 * ((j) - 32)) : ((j) < 4 ? ML + b * CT + 64 * (j) : b * T + 64 * ((j) - 4)))
    bf16x8 qf[KS];
    const bf16* qbase = MODE == 0 ? A.QKV + (size_t)qrow0 * NQ + h * 128 + side * 64 : A.MQK + (size_t)qrow0 * D + h * 128;
    unsigned qoff = (unsigned)(r32 * (MODE == 0 ? NQ : D) + 8 * hi) * 2u;
#define LOAD_Q() do { _Pragma("unroll") for (int d0 = 0; d0 < KS; ++d0) qf[d0] = *(const bf16x8*)((const char*)qbase + qoff + 32 * d0); } while (0)
    if (MODE == 0) LOAD_Q();
    float rowv = 0.f;
    if (MODE == 1) rowv = A.scan[SC_ROW + (size_t)(side * 32 + b * 4 + h) * TT + (isctx ? 0 : CT) + 128 * qt + 32 * qblk + r32];
    f32x16 o[4];
#pragma unroll
    for (int d0 = 0; d0 < 4; ++d0)
#pragma unroll
        for (int i = 0; i < 16; ++i) o[d0][i] = 0.f;
    float lsum = 0.f;
    u32x4 kr0, kr1, vr0, vr1; float cr = 0.f;
#define LOAD_TILE(j) do { const int tr0_ = TILE_ROW0(j); const char* kt_ = (const char*)(Ksrc + (size_t)tr0_ * Kld); const char* vt_ = (const char*)(Vsrc + (size_t)tr0_ * NQ); \
        kr0 = *(const u32x4*)(kt_ + koff0); kr1 = *(const u32x4*)(kt_ + koff1); vr0 = *(const u32x4*)(vt_ + voff0); vr1 = *(const u32x4*)(vt_ + voff1); \
        if (MODE == 1 && wid < 2) cr = colsrc[(unsigned)(64 * (j) + lane)]; } while (0)
#define STORE_TILE(slot) do { LAS unsigned char* d_ = lds + (slot) * 32768; \
        *(LAS u32x4*)(d_ + kdst0) = kr0; *(LAS u32x4*)(d_ + kdst1) = kr1; *(LAS u32x4*)(d_ + vdst0) = vr0; *(LAS u32x4*)(d_ + vdst1) = vr1; \
        if (MODE == 1 && wid < 2) ((LAS float*)(lds + SMALL_OFF + 2048 + (slot) * 512))[tid] = cr; } while (0)
    const unsigned vb = ((lane >> 4) & 1) * 32 + (lane & 3) * 8 + (4 * hi + ((lane & 15) >> 2)) * 64;
#define QK_S(P0, P1, Kb_) do { float nm_ = MODE == 0 ? A.negm : 0.f; if (MODE == 0) asm volatile("" : "+v"(nm_));     \
        _Pragma("unroll") for (int i = 0; i < 16; ++i) { P0[i] = nm_; P1[i] = nm_; } \
        _Pragma("unroll") for (int d0 = 0; d0 < KS; ++d0) { const int ck = (MODE == 0 ? side * 8 : 0) + 2 * d0 + hi; \
            const bf16x8 k0 = *(const LAS bf16x8*)((Kb_) + ck * 1024 + ((r32 ^ ck) << 4)); const bf16x8 k1 = *(const LAS bf16x8*)((Kb_) + ck * 1024 + (((r32 + 32) ^ ck) << 4)); \
            P0 = __builtin_amdgcn_mfma_f32_32x32x16_bf16(k0, qf[d0], P0, 0, 0, 0); P1 = __builtin_amdgcn_mfma_f32_32x32x16_bf16(k1, qf[d0], P1, 0, 0, 0); } } while (0)
#define PV_LOADF(L, H, d0_) do { const LAS unsigned char* vp_ = vbase_ + (d0_) * 4096 + (vb ^ ((d0_) << 6)); \
        _Pragma("unroll") for (int ks = 0; ks < 4; ++ks) { L[ks] = vtr(vp_ + ks * 1024); H[ks] = vtr(vp_ + ks * 1024 + 512); } } while (0)
#define PV_MMA(L, H, d0_) do { \
        o[d0_] = __builtin_amdgcn_mfma_f32_32x32x16_bf16(pa0, __builtin_shufflevector(L[0], H[0], 0, 1, 2, 3, 4, 5, 6, 7), o[d0_], 0, 0, 0); o[d0_] = __builtin_amdgcn_mfma_f32_32x32x16_bf16(pa1, __builtin_shufflevector(L[1], H[1], 0, 1, 2, 3, 4, 5, 6, 7), o[d0_], 0, 0, 0); \
        o[d0_] = __builtin_amdgcn_mfma_f32_32x32x16_bf16(pa2, __builtin_shufflevector(L[2], H[2], 0, 1, 2, 3, 4, 5, 6, 7), o[d0_], 0, 0, 0); o[d0_] = __builtin_amdgcn_mfma_f32_32x32x16_bf16(pa3, __builtin_shufflevector(L[3], H[3], 0, 1, 2, 3, 4, 5, 6, 7), o[d0_], 0, 0, 0); } while (0)
#define PV_O1(P0, P1, Vb_) do { const LAS unsigned char* vbase_ = (Vb_); const bf16x8 pa0 = pack8(P0, 0), pa1 = pack8(P0, 1), pa2 = pack8(P1, 0), pa3 = pack8(P1, 1); \
        _Pragma("unroll") for (int d0 = 0; d0 < 4; ++d0) { s16x4 la[4], ha[4]; PV_LOADF(la, ha, d0); PV_MMA(la, ha, d0); } } while (0)
#define PV_LD2(L, H, d0_, k0_) do { const LAS unsigned char* vp_ = vbase_ + va[d0_]; \
        L[0] = vtr(vp_ + (k0_) * 1024); H[0] = vtr(vp_ + (k0_) * 1024 + 512); L[1] = vtr(vp_ + (k0_) * 1024 + 1024); H[1] = vtr(vp_ + (k0_) * 1024 + 1536); } while (0)
#define PV_MM2(L, H, d0_, PA, PB) do { \
        o[d0_] = __builtin_amdgcn_mfma_f32_32x32x16_bf16(PA, __builtin_shufflevector(L[0], H[0], 0, 1, 2, 3, 4, 5, 6, 7), o[d0_], 0, 0, 0); \
        o[d0_] = __builtin_amdgcn_mfma_f32_32x32x16_bf16(PB, __builtin_shufflevector(L[1], H[1], 0, 1, 2, 3, 4, 5, 6, 7), o[d0_], 0, 0, 0); } while (0)
#define PV_O(P0, P1, Vb_) do { const LAS unsigned char* vbase_ = (Vb_); s16x4 la[2], ha[2], lb[2], hb[2]; \
        PV_LD2(la, ha, 0, 0); PV_LD2(lb, hb, 0, 2); \
        const bf16x8 pa0 = pack8(P0, 0), pa1 = pack8(P0, 1), pa2 = pack8(P1, 0), pa3 = pack8(P1, 1); \
        __builtin_amdgcn_sched_barrier(0); PV_MM2(la, ha, 0, pa0, pa1); PV_LD2(la, ha, 1, 0); \
        __builtin_amdgcn_sched_barrier(0); PV_MM2(lb, hb, 0, pa2, pa3); PV_LD2(lb, hb, 1, 2); \
        __builtin_amdgcn_sched_barrier(0); PV_MM2(la, ha, 1, pa0, pa1); PV_LD2(la, ha, 2, 0); \
        __builtin_amdgcn_sched_barrier(0); PV_MM2(lb, hb, 1, pa2, pa3); PV_LD2(lb, hb, 2, 2); \
        __builtin_amdgcn_sched_barrier(0); PV_MM2(la, ha, 2, pa0, pa1); PV_LD2(la, ha, 3, 0); \
        __builtin_amdgcn_sched_barrier(0); PV_MM2(lb, hb, 2, pa2, pa3); PV_LD2(lb, hb, 3, 2); \
        __builtin_amdgcn_sched_barrier(0); PV_MM2(la, ha, 3, pa0, pa1); \
        __builtin_amdgcn_sched_barrier(0); PV_MM2(lb, hb, 3, pa2, pa3); } while (0)
#define QK0(P0, P1, Kb_) do { const LAS unsigned char* kb_ = (Kb_); \
        _Pragma("unroll") for (int d0 = 0; d0 < 4; ++d0) { const bf16x8 k0 = *(const LAS bf16x8*)(kb_ + ka[d0]), k1 = *(const LAS bf16x8*)(kb_ + ka[d0] + 512); \
            if (d0 == 0) { P0 = __builtin_amdgcn_mfma_f32_32x32x16_bf16(k0, qf[0], zero16, 0, 0, 0); P1 = __builtin_amdgcn_mfma_f32_32x32x16_bf16(k1, qf[0], zero16, 0, 0, 0); } \
            else { P0 = __builtin_amdgcn_mfma_f32_32x32x16_bf16(k0, qf[d0], P0, 0, 0, 0); P1 = __builtin_amdgcn_mfma_f32_32x32x16_bf16(k1, qf[d0], P1, 0, 0, 0); } } } while (0)
#define VFRG(k) (bf16x8){lo[k][0], lo[k][1], lo[k][2], lo[k][3], hh[k][0], hh[k][1], hh[k][2], hh[k][3]}
    if constexpr (MODE == 0) {
        const int nt = jhi - jlo, rot = isctx ? 0 : (qt * nt) >> 4;
        typedef float f32x2 __attribute__((ext_vector_type(2)));
        const f32x16 zero16 = {0.f, 0.f, 0.f, 0.f, 0.f, 0.f, 0.f, 0.f, 0.f, 0.f, 0.f, 0.f, 0.f, 0.f, 0.f, 0.f};
        unsigned ka[4], va[4];
#pragma unroll
        for (int d0 = 0; d0 < 4; ++d0) { const int ck = side * 8 + 2 * d0 + hi; ka[d0] = (unsigned)(ck * 1024 + ((r32 ^ ck) << 4)); va[d0] = (unsigned)(16384 + d0 * 4096) + (vb ^ (unsigned)(d0 << 6));
            asm volatile("" : "+v"(ka[d0]), "+v"(va[d0])); }
        const float negm = __builtin_bit_cast(float, __builtin_amdgcn_readfirstlane(__builtin_bit_cast(int, A.negm)));
        const bool shift = negm < -64.0f;
        f32x2 ls2 = {0.f, 0.f};
#define TJ(x) (jlo + (((x) - jlo + rot) >= nt ? ((x) - jlo + rot) - nt : ((x) - jlo + rot)))
        LOAD_TILE(TJ(jlo)); STORE_TILE(0); LOAD_TILE(TJ(jlo + 1)); STORE_TILE(1);
        __syncthreads();
        f32x16 s0, s1; QK0(s0, s1, lds);
        int cur = 0;
        for (int j = jlo; j < jhi; ++j) {
            const int nx = cur == 2 ? 0 : cur + 1, nn = nx == 2 ? 0 : nx + 1;
            const bool more1 = j + 1 < jhi, more2 = j + 2 < jhi;
            if (more2) LOAD_TILE(TJ(j + 2));
            if (shift) {
#pragma unroll
                for (int i = 0; i < 16; ++i) { s0[i] += negm; s1[i] += negm; } }
#pragma unroll
            for (int i = 0; i < 16; ++i) { s0[i] = __builtin_amdgcn_exp2f(s0[i]); s1[i] = __builtin_amdgcn_exp2f(s1[i]); }
#pragma unroll
            for (int i = 0; i < 8; ++i) { ls2 += (f32x2){s0[2 * i], s0[2 * i + 1]}; ls2 += (f32x2){s1[2 * i], s1[2 * i + 1]}; }
            PV_O(s0, s1, lds + cur * 32768);
            if (more1) QK0(s0, s1, lds + nx * 32768);
            if (more2) STORE_TILE(nn);
            cur = nx;
            __syncthreads();
        }
        lsum = ls2[0] + ls2[1];
    } else {
    {
        u32x4 tk0[4], tk1[4], tv0[4], tv1[4]; float tc[4];
#pragma unroll
        for (int t = 0; t < 4; ++t) { const int tr0_ = TILE_ROW0(jlo + t); const char* kt_ = (const char*)(Ksrc + (size_t)tr0_ * Kld); const char* vt_ = (const char*)(Vsrc + (size_t)tr0_ * NQ);
            tk0[t] = *(const u32x4*)(kt_ + koff0); tk1[t] = *(const u32x4*)(kt_ + koff1); tv0[t] = *(const u32x4*)(vt_ + voff0); tv1[t] = *(const u32x4*)(vt_ + voff1);
            tc[t] = wid < 2 ? colsrc[(unsigned)(64 * (jlo + t) + lane)] : 0.f; }
        LOAD_Q();
#pragma unroll
        for (int t = 0; t < 4; ++t) { LAS unsigned char* d_ = lds + t * 32768;
            *(LAS u32x4*)(d_ + kdst0) = tk0[t]; *(LAS u32x4*)(d_ + kdst1) = tk1[t]; *(LAS u32x4*)(d_ + vdst0) = tv0[t]; *(LAS u32x4*)(d_ + vdst1) = tv1[t];
            if (wid < 2) ((LAS float*)(lds + SMALL_OFF + 2048 + t * 512))[tid] = tc[t]; }
    }
    __syncthreads();
#pragma unroll 1
    for (int j = jlo; j < jhi; ++j) {
        const int cur = j - jlo;
        const bool masked = (j == jd), active = side == 0 ? (j <= jd) : (j >= jd);
        if (active) {
            const LAS unsigned char* Kb = lds + cur * 32768;
            f32x16 p0, p1;
            QK_S(p0, p1, Kb);
            {
                const LAS float* colp = (const LAS float*)(lds + SMALL_OFF + 2048 + cur * 512 + side * 256) + 4 * hi;
                const int qidx = 32 * (qblk & 1) + r32;
#pragma unroll
                for (int g = 0; g < 4; ++g) {
                    const f32x4 c0 = *(const LAS f32x4*)(colp + 8 * g), c1 = *(const LAS f32x4*)(colp + 32 + 8 * g);
#pragma unroll
                    for (int k = 0; k < 4; ++k) {
                        float e0 = rowv - c0[k], e1 = rowv - c1[k];
                        if (masked) { const int kv0 = 8 * g + 4 * hi + k, kv1 = kv0 + 32;
                            const bool keep0 = side == 0 ? (kv0 <= qidx) : (kv0 >= qidx), keep1 = side == 0 ? (kv1 <= qidx) : (kv1 >= qidx);
                            e0 = keep0 ? e0 : -1.0e30f; e1 = keep1 ? e1 : -1.0e30f; }
                        p0[4 * g + k] *= __builtin_amdgcn_exp2f(e0); p1[4 * g + k] *= __builtin_amdgcn_exp2f(e1);
                    }
                }
            }
            float ts = 0.f;
#pragma unroll
            for (int i = 0; i < 16; ++i) ts += p0[i] + p1[i];
            lsum += ts;
            PV_O1(p0, p1, Kb + 16384);
        }
    }
    __syncthreads();
    }
#undef TJ
#undef VFRG
#undef PV_LOADF
#undef PV_LD2
#undef QK0
#undef PV_MM2
#undef PV_O1
#undef PV_MMA
#undef QK_S
#undef PV_O
    if (MODE == 1 && !isctx) {
        const int slot0 = kq - 1, slot1 = kq == 8 ? 0 : kq + 1;
        {
            int tid2 = tid; asm volatile("" : "+v"(tid2));
            const int c16s = tid2 & 15, rr = tid2 >> 4;
#pragma unroll 1
            for (int d = 0; d < 2; ++d) { const float* src = A.DC + ((size_t)(((d * 32 + b * 4 + h) * 9) + (d ? slot1 : slot0)) << 14) + rr * 128 + 8 * c16s;
                f32x4 x0[4], x1[4];
#pragma unroll
                for (int g = 0; g < 4; ++g) { x0[g] = *(const f32x4*)(src + g * 4096); x1[g] = *(const f32x4*)(src + g * 4096 + 4); }
                asm volatile("" : "+v"(x0[0]), "+v"(x0[1]), "+v"(x0[2]), "+v"(x0[3]), "+v"(x1[0]), "+v"(x1[1]), "+v"(x1[2]), "+v"(x1[3]));
#pragma unroll
                for (int g = 0; g < 4; ++g) { u32x4 w; w.x = pk2(x0[g][0], x0[g][1]); w.y = pk2(x0[g][2], x0[g][3]); w.z = pk2(x1[g][0], x1[g][1]); w.w = pk2(x1[g][2], x1[g][3]);
                    *(LAS u32x4*)(lds + d * 32768 + (c16s >> 2) * 8192 + (rr + 32 * g) * 64 + (c16s & 3) * 16) = w; } }
            if (tid2 < 64) { const int d = tid2 >> 5; *(LAS f32x4*)(lds + SMALL_OFF + 4096 + d * 512 + (tid2 & 31) * 16) = *(const f32x4*)(A.scan + SC_DN + ((d * 32 + b * 4 + h) * 9 + (d ? slot1 : slot0)) * 128 + (tid2 & 31) * 4); }
        }
        const int uref = side == 0 ? 256 * kq - 1 : 256 * slot1;
        const float rt = __builtin_amdgcn_exp2f(rowv - A.scan[SC_ROW + (size_t)(side * 32 + b * 4 + h) * TT + uref]);
        int lane2 = lane; asm volatile("" : "+v"(lane2));
        __syncthreads();
        const LAS float* nst = (const LAS float*)(lds + SMALL_OFF + 4096 + side * 512) + 8 * (lane2 >> 5);
        float qn = 0.f;
#pragma unroll
        for (int d0 = 0; d0 < KS; ++d0) {
            const f32x4 n0 = *(const LAS f32x4*)(nst + 16 * d0), n1 = *(const LAS f32x4*)(nst + 16 * d0 + 4);
            const u32x4 qw = __builtin_bit_cast(u32x4, qf[d0]); u32x4 ow;
#pragma unroll
            for (int i = 0; i < 4; ++i) { const float lo_ = bf2f(qw[i] & 0xffffu), hi_ = bf2f(qw[i] >> 16);
                qn += lo_ * (i < 2 ? n0[2 * i] : n1[2 * i - 4]) + hi_ * (i < 2 ? n0[2 * i + 1] : n1[2 * i - 3]);
                ow[i] = pk2(lo_ * rt, hi_ * rt); }
            qf[d0] = __builtin_bit_cast(bf16x8, ow);
        }
        lsum += rt * qn;
        const unsigned vbn = ((lane2 >> 4) & 1) * 32 + (lane2 & 3) * 8 + (8 * (lane2 >> 5) + ((lane2 & 15) >> 2)) * 64;
        const LAS unsigned char* Cb = lds + side * 32768 + vbn;
#pragma unroll
        for (int d0 = 0; d0 < 4; ++d0)
#pragma unroll
            for (int ks = 0; ks < KS; ++ks) { const s16x4 bl = vtr(Cb + d0 * 8192 + ks * 1024), bh = vtr(Cb + d0 * 8192 + ks * 1024 + 256);
                o[d0] = __builtin_amdgcn_mfma_f32_32x32x16_bf16(qf[ks], (bf16x8){bl[0], bl[1], bl[2], bl[3], bh[0], bh[1], bh[2], bh[3]}, o[d0], 0, 0, 0); }
        __syncthreads();
    }
    int le = lane; asm volatile("" : "+v"(le));
    const int r32e = le & 31, hie = le >> 5;
    {
        float tot = lsum + __builtin_bit_cast(float, __builtin_amdgcn_ds_bpermute((le ^ 32) << 2, __builtin_bit_cast(int, lsum))), inv;
        if (MODE == 0) inv = 1.0f / tot;
        else { const float fl = expf(-A.scan[SC_LMX + side * 32 + b * 4 + h]); inv = 1.0f / fmaxf(fabsf(tot), fl); }
        LAS float* wsf = (LAS float*)(lds + SMALL_OFF + 1024 + wid * 128);
        if (hie == 0) wsf[r32e] = inv;
        LDS_WAIT();
#pragma unroll
        for (int i = 0; i < 16; ++i) { const float li = wsf[crow(i, hie)];
#pragma unroll
            for (int d0 = 0; d0 < 4; ++d0) o[d0][i] *= li; }
    }
    LAS float* xch = (LAS float*)(lds + qblk * 16384);
    if (side == 1) {
#pragma unroll
        for (int d0 = 0; d0 < 4; ++d0)
#pragma unroll
            for (int i = 0; i < 16; ++i) xch[(d0 * 16 + i) * 64 + le] = o[d0][i];
    }
    __syncthreads();
    if (side == 0) {
#pragma unroll
        for (int d0 = 0; d0 < 4; ++d0)
#pragma unroll
            for (int i = 0; i < 16; ++i) { const float x2 = xch[(d0 * 16 + i) * 64 + le]; o[d0][i] = MODE == 0 ? o[d0][i] - A.lam * x2 : o[d0][i] + x2; }
    }
    __syncthreads();
    if (side == 0) {
        LAS float* rb = (LAS float*)lds + (qblk * 32 + 4 * hie) * 132 + r32e;
#pragma unroll
        for (int d0 = 0; d0 < 4; ++d0)
#pragma unroll
            for (int i = 0; i < 16; ++i) rb[((i & 3) + 8 * (i >> 2)) * 132 + 32 * d0] = o[d0][i];
    }
    __syncthreads();
    {
        int tid3 = wid * 64 + le; asm volatile("" : "+v"(tid3));
        const int urow0 = (isctx ? ML + b * CT : b * T) + 128 * qt;
#pragma unroll
        for (int it = 0; it < 4; ++it) {
            const int idx = tid3 + 512 * it, row = idx >> 4, seg = idx & 15;
            const LAS float* rp = (const LAS float*)lds + row * 132 + 8 * seg;
            const f32x4 a0 = *(const LAS f32x4*)rp, a1 = *(const LAS f32x4*)(rp + 4);
            float ss = (a0[0] * a0[0] + a0[1] * a0[1]) + (a0[2] * a0[2] + a0[3] * a0[3]) + (a1[0] * a1[0] + a1[1] * a1[1]) + (a1[2] * a1[2] + a1[3] * a1[3]);
            ss += __shfl_xor(ss, 1); ss += __shfl_xor(ss, 2); ss += __shfl_xor(ss, 4); ss += __shfl_xor(ss, 8);
            const float rstd = 1.0f / sqrtf(ss * (1.0f / 128.0f) + EPS);
            const float* gp = A.gain + (MODE == 0 ? 0 : h * 128) + 8 * seg;
            f32x4 g0 = *(const f32x4*)gp, g1 = *(const f32x4*)(gp + 4);
            const size_t grow = (size_t)(urow0 + row);
            if (MODE == 0) { g0 = g0 * (rstd * A.post); g1 = g1 * (rstd * A.post); }
            else { const u32x4 og = *(const u32x4*)(A.QKV + grow * NQ + 3072 + h * 128 + 8 * seg);
#pragma unroll
                for (int k = 0; k < 4; ++k) { const float s0 = 1.0f / (1.0f + expf(-bf2f(og[k] & 0xffffu))), s1 = 1.0f / (1.0f + expf(-bf2f(og[k] >> 16)));
                    if (k < 2) { g0[2 * k] *= rstd * s0; g0[2 * k + 1] *= rstd * s1; } else { g1[2 * k - 4] *= rstd * s0; g1[2 * k - 3] *= rstd * s1; } } }
            const f32x4 v0 = a0 * g0, v1 = a1 * g1;
            u32x4 w; w.x = pk2(v0[0], v0[1]); w.y = pk2(v0[2], v0[3]); w.z = pk2(v1[0], v1[1]); w.w = pk2(v1[2], v1[3]);
            *(u32x4*)(A.CAT + grow * D + (MODE == 0 ? 0 : 512) + h * 128 + 8 * seg) = w;
        }
    }
    __syncthreads();
#undef LOAD_TILE
#undef LOAD_Q
#undef STORE_TILE
#undef TILE_ROW0
}
DI void mixer_phase(const Frame& F, int l, bool need_ctx, int part) {
    const KArgs ka = kargs(); unsigned char* ws = ka->ws;
    LAS float* sm = (LAS float*)(F.lds + SMALL_OFF);
    if (F.wave == 0) {
        const int ln = F.lane;
        const float s1 = wave_sum(ka->in[I_LQ1][l * 64 + ln] * ka->in[I_LK1][l * 64 + ln]), s2 = wave_sum(ka->in[I_LQ2][l * 64 + ln] * ka->in[I_LK2][l * 64 + ln]);
        const float mq = wave_max(fabsf(ka->in[I_QNG][l * 64 + ln])), mk = wave_max(fabsf(ka->in[I_KNG][l * 64 + ln]));
        const float lam_init = 0.8f - 0.6f * expf(-0.3f * (float)l);
        if (ln == 0) { sm[0] = expf(s1) - expf(s2) + lam_init; sm[1] = 1.0f - lam_init; sm[2] = -(8.0f * mq * mk * LOG2E); }
    }
    __syncthreads();
    MixArgs A; A.QKV = (const bf16*)(ws + WS_QKV); A.MQK = (const bf16*)(ws + WS_H); A.CAT = (bf16*)(ws + WS_CAT); A.scan = (const float*)(ws + WS_SCAN); A.DC = (const float*)(ws + WS_DC);
    A.lam = sm[0]; A.post = sm[1]; A.negm = sm[2];
    const int nunits = need_ctx ? 576 : 512;
    if (part == 1) {
        A.gain = ka->in[I_MNG] + l * 512;
        for (int u = F.vcu; u < nunits; u += F.G) {
            const bool isctx = u >= 512; const int v = u - 512;
            mix_unit<1>(F, A, isctx ? v >> 3 : u >> 6, isctx ? (v >> 1) & 3 : (u >> 4) & 3, isctx ? v & 1 : u & 15, isctx);
        }
    }
    A.gain = ka->in[I_SUBLN] + l * 128;
    for (int u = (part == 0 ? F.vcu : 256 + (F.vcu + F.G - 64) % F.G); u < (part == 0 ? 256 : nunits); u += F.G) {
        const bool isctx = u >= 512; const int v = u - 512;
        mix_unit<0>(F, A, isctx ? v >> 3 : u >> 6, isctx ? (v >> 1) & 3 : (u >> 4) & 3, isctx ? v & 1 : u & 15, isctx);
    }
}

constexpr int CW_PROF = 2048;
constexpr int MOE_TAIL_PM = 64, MOE_TS = 7;
DI void moe_tstart(const Frame& F, const unsigned char* ws, int half) {
    LAS int* ts = (LAS int*)(F.lds + SMALL_OFF + 64);
    if (F.tid == 0) { const unsigned* cnt = (const unsigned*)(ws + WS_CTL) + CW_CNT + half * 8; int acc = 0;
        for (int e = 0; e < 8; ++e) { ts[e] = acc; acc += ((int)__hip_atomic_load(cnt + e, RLX_AGENT) + 255) >> 8; } ts[8] = acc; }
    __syncthreads();
}
DI void moe_gather(const Frame& F, unsigned char* ws, int half) {
    moe_tstart(F, ws, half);
    const LAS int* ts = (const LAS int*)(F.lds + SMALL_OFF + 64);
    const bf16* H = (const bf16*)(ws + WS_H); bf16* HG = (bf16*)(ws + WS_CAT);
    int* rowmap = (int*)(ws + WS_SMALL + SM_ROWMAP) + half * MR; float* roww = (float*)(ws + WS_SMALL + SM_ROWW) + half * MR;
    const int gw = F.vcu * NWAVES + F.wave, NGW = F.G * NWAVES;
#pragma unroll 4
    for (int tk = gw; tk < ML / 2; tk += NGW) {
        const int token = half * (ML / 2) + tk;
        const u32x4* rec = (const u32x4*)(ws + WS_SMALL + SM_ROUTE + (size_t)token * 32);
        const u32x4 r0 = rec[0], r1 = rec[1];
        const u32x4 v0 = *((const u32x4*)((const unsigned char*)H + (size_t)token * D) + F.lane);
#pragma unroll
        for (int s = 0; s < 2; ++s) {
            const int e = (int)(s ? r0.y : r0.x), pos = (int)(s ? r0.w : r0.z); const int dst = 256 * ts[e] + pos;
            *((u32x4*)((unsigned char*)HG + (size_t)dst * D) + F.lane) = v0;
            if (F.lane == 0) { rowmap[dst] = token * 2 + s; roww[dst] = __uint_as_float(s ? r1.y : r1.x); }
        }
    }
    const unsigned* cnt = (const unsigned*)(ws + WS_CTL) + CW_CNT + half * 8;
    for (int pr = gw; pr < 8 * 256; pr += NGW) {
        const int e = pr >> 8, k = pr & 255; const int c = (int)__hip_atomic_load(cnt + e, RLX_AGENT); const int npad = (((c + 255) >> 8) << 8) - c;
        if (k < npad) { const int dst = 256 * ts[e] + c + k; *((u32x4*)((unsigned char*)HG + (size_t)dst * D) + F.lane) = (u32x4){0u, 0u, 0u, 0u};
            if (F.lane == 0) { rowmap[dst] = -1; roww[dst] = 0.f; } }
    }
}
DI void moe_combine(const Frame& F, const unsigned char* ws, int half, float* out, const float* g2, int rank, int nrank) {
    const bf16* Y = (const bf16*)(ws + WS_Y); const bf16* YT = (const bf16*)(ws + WS_DC); const bf16* X1 = (const bf16*)(ws + WS_XA);
#ifdef PROF_MASK
    const float pscale = half == 0 ? 1.0f : 1.0f + sqrtf((float)__hip_atomic_load((const unsigned*)(ws + WS_CTL) + CW_PROF, RLX_AGENT) * 2e-8f);
#else
    const float pscale = 1.0f;
#endif
    LAS int* ts2 = (LAS int*)(F.lds + SMALL_OFF + 128);
    if (F.tid == 0) { const unsigned* cnt = (const unsigned*)(ws + WS_CTL) + CW_CNT + half * 8; int acc = 0;
        for (int e = 0; e < 8; ++e) { ts2[e] = acc; acc += ((int)__hip_atomic_load(cnt + e, RLX_AGENT) + 255) >> 8; } ts2[8] = acc; }
    __syncthreads();
    const int gw = rank * NWAVES + F.wave, NGW = nrank * NWAVES;
#pragma unroll 2
    for (int tk = gw; tk < ML / 2; tk += NGW) {
        const int token = half * (ML / 2) + tk;
        const float* gp = g2 + (token >> 11) * ADA_LD;
        const u32x4 r0 = *(const u32x4*)(ws + WS_SMALL + SM_ROUTE + (size_t)token * 32);
        const int dst0 = 256 * ts2[(int)r0.x] + (int)r0.z - MOE_TAIL_PM * 256, dst1 = 256 * ts2[(int)r0.y] + (int)r0.w - MOE_TAIL_PM * 256;
#pragma unroll
        for (int j = 0; j < 2; ++j) {
            const int c = 8 * F.lane + 512 * j;
            float ys[8];
#pragma unroll
            for (int i = 0; i < 8; ++i) ys[i] = 0.f;
#pragma unroll
            for (int s = 0; s < 2; ++s) { const int dst = s ? dst1 : dst0;
                if (dst < 0) { const u32x4 y = *(const u32x4*)(Y + (size_t)(2 * tk + s) * D + c);
#pragma unroll
                    for (int i = 0; i < 4; ++i) { ys[2 * i] += bf2f(y[i] & 0xffffu); ys[2 * i + 1] += bf2f(y[i] >> 16); } }
                else {
#pragma unroll
                    for (int q = 0; q < MOE_TS; ++q) { const u32x4 y = *(const u32x4*)(YT + ((size_t)q * 2048 + dst) * D + c);
#pragma unroll
                        for (int i = 0; i < 4; ++i) { ys[2 * i] += bf2f(y[i] & 0xffffu); ys[2 * i + 1] += bf2f(y[i] >> 16); } } }
            }
            const u32x4 xb = *(const u32x4*)(X1 + (size_t)token * D + c);
            const f32x4 g0 = *(const f32x4*)(gp + c), g1 = *(const f32x4*)(gp + c + 4);
            f32x4 o0, o1;
#pragma unroll
            for (int i = 0; i < 2; ++i) { o0[2 * i] = bf2f(xb[i] & 0xffffu) + g0[2 * i] * ys[2 * i]; o0[2 * i + 1] = bf2f(xb[i] >> 16) + g0[2 * i + 1] * ys[2 * i + 1];
                o1[2 * i] = bf2f(xb[2 + i] & 0xffffu) + g1[2 * i] * ys[4 + 2 * i]; o1[2 * i + 1] = bf2f(xb[2 + i] >> 16) + g1[2 * i + 1] * ys[5 + 2 * i]; }
            float* op = out + (size_t)token * D + c;
            *(f32x4*)op = o0 * pscale; *(f32x4*)(op + 4) = o1 * pscale;
        }
    }
}
DI void moe_up(const Frame& F, unsigned char* ws, int half) {
    moe_tstart(F, ws, half);
    pg8::Gemm g{(const bf16*)(ws + WS_CAT), (const bf16*)(ws + WS_MUP), MR, 2 * FFE, D / 2, D / 2}; pg8::MoeOrder S{(const LAS int*)(F.lds + SMALL_OFF + 64), 2 * FFE / 256, F.G, F.vcu, 1 << 20};
    pg8::EpiGated<true> E{(bf16*)(ws + WS_QKV), FFE, 2 * FFE / 256, 1.0f / (F8_SA * F8_SW), F8_SH};
    pg8::gemm_phase<pg8::EpiGated<true>, pg8::MoeOrder, PG8_ALIGN, PG8_SP2, true>(F.lds, g, S, E);
}
DI void moe_down(const Frame& F, unsigned char* ws, int half) {
    moe_tstart(F, ws, half);
    const int* rowmap = (const int*)(ws + WS_SMALL + SM_ROWMAP) + half * MR; const float* roww = (const float*)(ws + WS_SMALL + SM_ROWW) + half * MR;
    {
        pg8::Gemm g{(const bf16*)(ws + WS_QKV), (const bf16*)(ws + WS_MDN), MR, D, FFE / 2, FFE / 2}; pg8::MoeOrder S{(const LAS int*)(F.lds + SMALL_OFF + 64), D / 256, F.G, F.vcu, MOE_TAIL_PM};
        pg8::EpiScatter E{(bf16*)(ws + WS_Y), rowmap, roww, half * ML, 1.0f / (F8_SH * F8_SW)};
        pg8::gemm_phase<pg8::EpiScatter, pg8::MoeOrder, PG8_ALIGN, PG8_SP2, true>(F.lds, g, S, E);
    }
    __syncthreads();
    {
        int kpiece = FFE / (2 * MOE_TS); asm volatile("" : "+s"(kpiece));
        pg8::Gemm g{(const bf16*)(ws + WS_QKV), (const bf16*)(ws + WS_MDN), MR, D, kpiece, FFE / 2}; pg8::MoeTailOrder S{(const LAS int*)(F.lds + SMALL_OFF + 64), F.G, F.vcu, MOE_TAIL_PM, FFE / MOE_TS, MOE_TS};
        pg8::EpiScatterTail E{(bf16*)(ws + WS_DC), roww, FFE / MOE_TS, 1.0f / (F8_SH * F8_SW)};
        pg8::gemm_phase<pg8::EpiScatterTail, pg8::MoeTailOrder, false, PG8_SP2, true>(F.lds, g, S, E);
    }
}
#ifdef PROF_MASK
DI void prof_tick(LAS unsigned char* lds, int k) {
    if (blockIdx.x == 0 && threadIdx.x == 0) { LAS unsigned long long* P = (LAS unsigned long long*)(lds + SMALL_OFF + 6144); const unsigned long long now = __builtin_amdgcn_s_memrealtime();
        if ((PROF_MASK >> k) & 1) P[1] += now - P[0]; P[0] = now; }
}
#define PROF_TICK(k) prof_tick(plds, (k))
#else
#define PROF_TICK(k) do { } while (0)
#endif
#ifndef PHMASK
#define PHMASK 0x7FFFFF
#endif
#define IN(k) (((PHMASK >> (k)) & 1) && lo <= (k) && (k) < hi)
#define SEAM(k) do { if (!MK_PER_PHASE && IN((k) + 1)) { xcd_barrier(bar); PROF_TICK(k); } } while (0)
template <int L>
DI void layer_phases(const Frame& F0, const XcdBarrier& bar, const int lo, const int hi) {
    constexpr int l = L;
    LAS unsigned char* const plds = F0.lds; (void)plds;
    unsigned char* ws = kargs()->ws;
    const float* ada = (const float*)(ws + WS_ADA);
    bf16* const QKV = (bf16*)(ws + WS_QKV); bf16* const CAT = (bf16*)(ws + WS_CAT); bf16* const H = (bf16*)(ws + WS_H); bf16* const XA = (bf16*)(ws + WS_XA);
    float* const gates = (float*)(ws + WS_GATES); float* const scan = (float*)(ws + WS_SCAN);
        const int pb = 1 + 9 * l;
        const float* adal = ada + l * ADA_L;
        const void* xinL = l == 0 ? (const void*)kargs()->in[I_X] : (const void*)XA; const void* xinC = l == 0 ? (const void*)kargs()->in[I_CTX] : (const void*)(XA + (size_t)ML * D);
        if (IN(pb + 0)) { const Frame F = fresh(F0); modulate_phase<0, (l != 0), (l != 0)>(F, xinL, xinC, MR, kargs()->in[I_N1G] + l * D, adal, 0, 1024, H, (const float*)(ws + WS_SMALL + SM_GTAB) + l * 16384, gates, ws); SEAM(pb + 0); }
        if (IN(pb + 1)) { const Frame F = fresh(F0);
            scan_phase(F, gates, kargs()->in[I_GATEB] + l * 16, scan);
            pg8::StaticOrder S; S.init(MR, NQ, F.G, (int)blockIdx.x);
            const float* rope = (const float*)(ws + WS_SMALL + SM_ROPE);
            if constexpr (l == 0) {
                pg8::Gemm g{H, (const bf16*)(ws + WS_WIN), MR, NQ, D, D};
                pg8::EpiQKV<false> E{QKV, kargs()->in[I_QNG], kargs()->in[I_KNG], rope, rope + 1024, 1.0f};
                pg8::gemm_phase<pg8::EpiQKV<false>, pg8::StaticOrder, PG8_ALIGN, PG8_SP2>(F.lds, g, S, E);
            } else {
                pg8::Gemm g{H, (const bf16*)(ws + WS_WIN) + (size_t)NQ * D, MR, NQ, D / 2, D / 2};
                pg8::EpiQKV<true> E{QKV, kargs()->in[I_QNG] + 64, kargs()->in[I_KNG] + 64, rope, rope + 1024, 1.0f / (F8_SA * F8_SW)};
                pg8::gemm_phase<pg8::EpiQKV<true>, pg8::StaticOrder, PG8_ALIGN, PG8_SP2, true>(F.lds, g, S, E);
            }
            SEAM(pb + 1);
        }
        if (IN(pb + 2)) { const Frame F = fresh(F0);
            conv_phase(F, QKV, H, kargs()->in[I_CONVW] + l * 5 * 1024, kargs()->in[I_CONVB] + l * 1024);
            for (int u = F.vcu; u < 512; u += F.G) {
                const int bh = u >> 4, j = u & 15, dir = j >> 3, k = j < 8 ? j : (j == 8 ? 0 : j - 7);
                mstate_unit(F, QKV, H, scan, kargs()->in[I_CONVW] + l * 5 * 1024, kargs()->in[I_CONVB] + l * 1024, (float*)(ws + WS_DC), bh >> 2, bh & 3, k, dir);
            }
            SEAM(pb + 2);
        }
        if (IN(pb + 3)) { const Frame F = fresh(F0); mprefix_phase(F, scan, (float*)(ws + WS_DC)); __syncthreads(); mixer_phase(F, l, l == 0, 0); SEAM(pb + 3); }
        if (IN(pb + 4)) { const Frame F = fresh(F0); mixer_phase(F, l, l == 0, 1); SEAM(pb + 4); }
        if (IN(pb + 5)) { const Frame F = fresh(F0);
            const int M4 = l == 0 ? MR : ML;
            pg8::Gemm g{CAT, (const bf16*)(ws + WS_WOUT) + (size_t)l * D * D, M4, D, D, D}; pg8::StaticOrder S; S.init(M4, D, F.G, (int)blockIdx.x);
            typedef pg8::EpiRes<(l != 0), true> EpiP4;
            EpiP4 E{xinL, xinC, (void*)XA, adal + 2048};
            pg8::gemm_phase<EpiP4, pg8::StaticOrder, PG8_ALIGN, PG8_SP2>(F.lds, g, S, E);
            if (l == 0) idle_convert(F, (MR / 256) * (D / 256), CV_PRO, CV_P4);
            SEAM(pb + 5);
        }
        if (l == 0) {
            if (IN(pb + 6)) { const Frame F = fresh(F0); modulate_phase<1, true>(F, XA, XA + (size_t)ML * D, MR, kargs()->in[I_N2G], adal, 3072, 4096, H, nullptr, nullptr, ws); SEAM(pb + 6); }
            if (IN(pb + 7)) { const Frame F = fresh(F0);
                pg8::Gemm g{H, (const bf16*)(ws + WS_WUP), MR, 2 * FF, D, D}; pg8::StaticOrder S; S.init(MR, 2 * FF, F.G, (int)blockIdx.x);
                pg8::EpiGated<false> E{QKV, FF, 1 << 20, 1.0f, 1.0f};
                pg8::gemm_phase<pg8::EpiGated<false>, pg8::StaticOrder, PG8_ALIGN, PG8_SP2>(F.lds, g, S, E);
                idle_convert(F, (MR / 256) * (2 * FF / 256), CV_P4, CV_P6);
                SEAM(pb + 7);
            }
            if (IN(pb + 8)) { const Frame F = fresh(F0);
                pg8::Gemm g{QKV, (const bf16*)(ws + WS_WDN), MR, D, FF, FF}; pg8::StaticOrder S; S.init(MR, D, F.G, (int)blockIdx.x);
                typedef pg8::EpiRes<true, true> EpiP7;
                EpiP7 E{XA, XA + (size_t)ML * D, XA, adal + 5120};
                pg8::gemm_phase<EpiP7, pg8::StaticOrder, PG8_ALIGN, PG8_SP2>(F.lds, g, S, E);
                idle_convert(F, (MR / 256) * (D / 256), CV_P6, CV_ALL);
                SEAM(pb + 8);
            }
        } else {
            if (IN(16)) { const Frame F = fresh(F0); modulate_phase<2, true>(F, XA, XA, ML, kargs()->in[I_N2G] + D, adal, 3072, 4096, H, (const float*)(ws + WS_SMALL + SM_RTAB), nullptr, ws); SEAM(16); }
            if (IN(17)) { const Frame F = fresh(F0); moe_gather(F, ws, 0); SEAM(17); }
            if (IN(18)) { const Frame F = fresh(F0); moe_up(F, ws, 0); SEAM(18); }
            if (IN(19)) { const Frame F = fresh(F0); moe_down(F, ws, 0); __syncthreads(); moe_gather(F, ws, 1); SEAM(19); }
            if (IN(20)) { const Frame F = fresh(F0); moe_up(F, ws, 1);
                __syncthreads();
                {
                    const int nun = ((const LAS int*)(F.lds + SMALL_OFF + 64))[8] * (2 * FFE / 256), r = nun % F.G;
                    if (r == 0) moe_combine(F, ws, 0, kargs()->out, adal + 5120, F.vcu, F.G);
                    else if (F.vcu >= r) moe_combine(F, ws, 0, kargs()->out, adal + 5120, F.vcu - r, F.G - r);
                }
                SEAM(20); }
            if (IN(21)) { const Frame F = fresh(F0); moe_down(F, ws, 1); SEAM(21); }
#ifdef PROF_MASK
            if (IN(22)) { if (blockIdx.x == 0 && threadIdx.x == 0) { __hip_atomic_store((unsigned*)(ws + WS_CTL) + CW_PROF, (unsigned)((LAS unsigned long long*)(plds + SMALL_OFF + 6144))[1], RLX_AGENT); } xcd_barrier(bar); }
#endif
            if (IN(22)) { const Frame F = fresh(F0); moe_combine(F, ws, 1, kargs()->out, adal + 5120, F.vcu, F.G); }
        }
    }
#undef IN
#undef SEAM

constexpr int NPHASES = 23;
__global__ void __launch_bounds__(NWAVES * 64, 2) fwd_kernel(Args args) {
    extern __shared__ __attribute__((aligned(16))) unsigned char lds_raw[];
    Frame F;
    F.lds = (LAS unsigned char*)lds_raw;
    F.tid = threadIdx.x; F.lane = F.tid & 63; F.wave = __builtin_amdgcn_readfirstlane(F.tid >> 6);
    F.G = gridDim.x; { const int bx = blockIdx.x; F.vcu = (F.G % 8 == 0) ? (bx % 8) * (F.G / 8) + bx / 8 : bx; }
    unsigned char* ws = kargs()->ws;
    for (int u = F.tid; u < (LDS_BYTES - LDSCTL_OFF) / 4; u += NWAVES * 64) ((LAS unsigned*)(F.lds + LDSCTL_OFF))[u] = 0u;
    __syncthreads();
    XcdBarrier bar; bar.bar = (unsigned*)(ws + WS_CTL) + CW_BAR; bar.x = 0; bar.st = nullptr;
    if (!MK_PER_PHASE) bar = xcd_barrier_post((unsigned*)(ws + WS_CTL) + CW_BAR, (volatile LAS unsigned*)(F.lds + MISC_OFF) + 8);
    const int lo = kargs()->ph_lo, hi = kargs()->ph_hi;
    LAS unsigned char* const plds = F.lds; (void)plds;
#ifdef PROF_MASK
    if (blockIdx.x == 0 && threadIdx.x == 0) ((LAS unsigned long long*)(plds + SMALL_OFF + 6144))[0] = __builtin_amdgcn_s_memrealtime();
#endif
#ifndef PHMASK
#define PHMASK 0x7FFFFF
#endif
#define IN(k) (((PHMASK >> (k)) & 1) && lo <= (k) && (k) < hi)
#define SEAM(k) do { if (!MK_PER_PHASE && IN((k) + 1)) { xcd_barrier(bar); PROF_TICK(k); } } while (0)
    const float* ada = (const float*)(ws + WS_ADA);
    bf16* const QKV = (bf16*)(ws + WS_QKV); bf16* const CAT = (bf16*)(ws + WS_CAT); bf16* const H = (bf16*)(ws + WS_H); bf16* const XA = (bf16*)(ws + WS_XA);
    float* const gates = (float*)(ws + WS_GATES); float* const scan = (float*)(ws + WS_SCAN);

    if (IN(0)) { const Frame Fp = fresh(F); p0_prologue(Fp); SEAM(0); }

    layer_phases<0>(F, bar, lo, hi);
    layer_phases<1>(F, bar, lo, hi);
#undef IN
#undef SEAM
}

extern "C" void kernel_launch(void* const* d_in, const int* in_sizes, int n_in, void* d_out, int out_size, void* d_ws, size_t ws_size, hipStream_t stream) {
    static int grid = 0;
    if (grid == 0) {
        if (n_in != 28 || in_sizes[0] != ML * D || out_size != ML * D || ws_size < WS_END) { fprintf(stderr, "kernel_launch: unexpected shapes / workspace (n_in %d, out %d, ws %zu < %zu)\n", n_in, out_size, ws_size, (size_t)WS_END); grid = -1; return; }
        int dev = 0, cus = 0, per_cu = 0;
        if (hipGetDevice(&dev) != hipSuccess || hipDeviceGetAttribute(&cus, hipDeviceAttributeMultiprocessorCount, dev) != hipSuccess) { grid = -1; return; }
        if (hipFuncSetAttribute((const void*)fwd_kernel, hipFuncAttributeMaxDynamicSharedMemorySize, LDS_BYTES) != hipSuccess) { fprintf(stderr, "kernel_launch: hipFuncSetAttribute failed\n"); grid = -1; return; }
        if (hipOccupancyMaxActiveBlocksPerMultiprocessor(&per_cu, (const void*)fwd_kernel, NWAVES * 64, LDS_BYTES) != hipSuccess || per_cu < 1) { fprintf(stderr, "kernel_launch: occupancy query says %d\n", per_cu); }
        (void)hipGetLastError();
        grid = cus;
    }
    if (grid < 0) return;
    if (hipMemsetAsync((char*)d_ws + WS_CTL, 0, CTL_ZERO_BYTES, stream) != hipSuccess) return;
    Args a{};
    for (int i = 0; i < 28; ++i) a.in[i] = (const float*)d_in[i];
    a.out = (float*)d_out; a.ws = (unsigned char*)d_ws;
#if MK_PER_PHASE
    for (int p = 0; p < NPHASES; ++p) { a.ph_lo = p; a.ph_hi = p + 1; hipLaunchKernelGGL(fwd_kernel, dim3(grid), dim3(NWAVES * 64), LDS_BYTES, stream, a); }
#else
    a.ph_lo = 0; a.ph_hi = NPHASES;
    hipLaunchKernelGGL(fwd_kernel, dim3(grid), dim3(NWAVES * 64), LDS_BYTES, stream, a);
#endif
}
```
